# Optimizing an MI355X kernel written in HIP

```python
import numpy as np
import jax
import jax.numpy as jnp
from jax import lax


D_MODEL = 1024
BATCH = 4
SEQ = 4096
DEPTH = 2

MIX_WIDTH = D_MODEL
NSA_WIDTH = MIX_WIDTH // 2
MLSTM_WIDTH = MIX_WIDTH - NSA_WIDTH
NSA_HEADS = 8
NSA_KV_HEADS = 2
NSA_HEAD_DIM = NSA_WIDTH // NSA_HEADS
NSA_BRANCHES = 3
CMP_LEN = 32
CMP_STRIDE = 16
CMP_HIDDEN = 128
SEL_BLOCK = 64
SEL_TOP = 16
WINDOW = 512
Q_BLOCK = 128
FORCE_BONUS = 1e4
NEG_INF = -1e30
MLSTM_HEADS = 4
MLSTM_HEAD_DIM = MLSTM_WIDTH // MLSTM_HEADS
MLSTM_CHUNK = 64
CONV_WIDTH = 4
D_FF = 2816
N_EXPERTS = 8
TOP_K = 2
D_FF_EXPERT = 3584
MOE_BLOCK = 256
EPS = 1e-6
N_DENSE_LAYERS = (DEPTH + 1) // 2
N_MOE_LAYERS = DEPTH // 2
NSA_KV_COLS = 2 * NSA_BRANCHES * NSA_KV_HEADS * NSA_HEAD_DIM
IN_SIZES = (NSA_WIDTH, NSA_KV_COLS, NSA_HEADS * NSA_BRANCHES, 2 * MLSTM_WIDTH, MLSTM_WIDTH, MLSTM_WIDTH, MLSTM_HEADS, MLSTM_HEADS)
IN_COLS = sum(IN_SIZES)

kernel_name = 'hybrid_nsa_mlstm_moe_block'


def _split_points():
    return [int(v) for v in np.cumsum(IN_SIZES)[:-1]]


def rmsnorm(x, g):
    x32 = x.astype(jnp.float32)
    y = x32 * lax.rsqrt(jnp.mean(x32 * x32, axis=-1, keepdims=True) + EPS)
    return (y * g.astype(jnp.float32)).astype(x.dtype)


def alibi_slopes(n):
    return jnp.asarray(2.0 ** (-8.0 * np.arange(1, n + 1) / n), dtype=jnp.float32)


def overlap_matrix(n_cmp, n_sel):
    lo_c = np.arange(n_cmp)[:, None] * CMP_STRIDE
    lo_s = np.arange(n_sel)[None, :] * SEL_BLOCK
    ov = np.minimum(lo_c + CMP_LEN, lo_s + SEL_BLOCK) - np.maximum(lo_c, lo_s)
    return jnp.asarray(np.clip(ov, 0, None) / CMP_LEN, dtype=jnp.float32)


def masked_softmax(s, mask):
    return jax.nn.softmax(jnp.where(mask, s, NEG_INF), axis=-1)


def compress_blocks(kv, pe, w1, w2):
    B, S, G, dh = kv.shape
    n_sub = CMP_LEN // CMP_STRIDE
    ch = kv.reshape(B, S // CMP_STRIDE, CMP_STRIDE, G, dh)
    n_cmp = ch.shape[1] - n_sub + 1
    blocks = jnp.concatenate([ch[:, i:i + n_cmp] for i in range(n_sub)], axis=2)
    blocks = blocks + pe[None, None, :, None, :]
    flat = blocks.transpose(0, 1, 3, 2, 4).reshape(B, n_cmp, G, CMP_LEN * dh)
    return jax.nn.silu(flat @ w1) @ w2


def nsa_attention(q, kv, gate_logits, cmp_pe, cmp_w1, cmp_w2):
    B, S, H, dh = q.shape
    G = NSA_KV_HEADS
    R = H // G
    f32 = jnp.float32
    k_c = compress_blocks(kv[:, :, 0], cmp_pe[0], cmp_w1[0], cmp_w2[0])
    v_c = compress_blocks(kv[:, :, 1], cmp_pe[1], cmp_w1[1], cmp_w2[1])
    n_cmp = k_c.shape[1]
    cmp_end = jnp.arange(n_cmp) * CMP_STRIDE + CMP_LEN - 1
    n_sel = S // SEL_BLOCK
    n_top = min(SEL_TOP, n_sel)
    k_s = kv[:, :, 2].reshape(B, n_sel, SEL_BLOCK, G, dh).transpose(0, 3, 1, 2, 4)
    v_s = kv[:, :, 3].reshape(B, n_sel, SEL_BLOCK, G, dh).transpose(0, 3, 1, 2, 4)
    pad = ((0, 0), (WINDOW, 0), (0, 0), (0, 0))
    k_w = jnp.pad(kv[:, :, 4], pad)
    v_w = jnp.pad(kv[:, :, 5], pad)
    slopes = alibi_slopes(H).reshape(G, R)
    ov = overlap_matrix(n_cmp, n_sel)
    gates = jax.nn.sigmoid(gate_logits.astype(f32)).reshape(B, S, G, R, NSA_BRANCHES)
    n_qb = S // Q_BLOCK
    q_blocks = (q * (dh ** -0.5)).reshape(B, n_qb, Q_BLOCK, G, R, dh).swapaxes(0, 1)
    g_blocks = gates.reshape(B, n_qb, Q_BLOCK, G, R, NSA_BRANCHES).swapaxes(0, 1)
    bi = jnp.arange(B)[:, None, None, None]
    gi = jnp.arange(G)[None, :, None, None]
    j_sel = jnp.arange(n_sel)

    def block_fn(args):
        qb, gb, blk = args
        t = blk * Q_BLOCK + jnp.arange(Q_BLOCK)
        s_c = jnp.einsum('bqgrd,bngd->bgrqn', qb, k_c).astype(f32)
        dist_c = (t[:, None] - cmp_end[None, :]).astype(f32)
        s_c = s_c - slopes[:, :, None, None] * dist_c
        mask_c = cmp_end[None, :] <= t[:, None]
        p_c = masked_softmax(s_c, mask_c) * jnp.any(mask_c, axis=-1)[:, None]
        o_c = jnp.einsum('bgrqn,bngd->bqgrd', p_c.astype(v_c.dtype), v_c)
        imp = jnp.einsum('bgrqn,nj->bgqj', p_c, ov)
        cur = t // SEL_BLOCK
        valid_j = j_sel[None, :] <= cur[:, None]
        forced = (j_sel[None, :] == 0) | (j_sel[None, :] == cur[:, None]) | (j_sel[None, :] == cur[:, None] - 1)
        imp = jnp.where(forced, imp + FORCE_BONUS, imp)
        imp = jnp.where(valid_j, imp, -1.0)
        _, idx = lax.top_k(imp, n_top)
        kg = k_s[bi, gi, idx]
        vg = v_s[bi, gi, idx]
        s_s = jnp.einsum('bqgrd,bgqnkd->bgrqnk', qb, kg).astype(f32)
        pos_s = idx[..., None] * SEL_BLOCK + jnp.arange(SEL_BLOCK)
        dist_s = t[None, None, :, None, None] - pos_s
        s_s = s_s - slopes[None, :, :, None, None, None] * dist_s[:, :, None].astype(f32)
        mask_s = (dist_s >= 0)[:, :, None]
        p_s = masked_softmax(s_s.reshape(B, G, R, Q_BLOCK, n_top * SEL_BLOCK),
                             mask_s.reshape(B, G, 1, Q_BLOCK, n_top * SEL_BLOCK)).reshape(s_s.shape)
        o_s = jnp.einsum('bgrqnk,bgqnkd->bqgrd', p_s.astype(vg.dtype), vg)
        k_blk = lax.dynamic_slice_in_dim(k_w, blk * Q_BLOCK, Q_BLOCK + WINDOW, axis=1)
        v_blk = lax.dynamic_slice_in_dim(v_w, blk * Q_BLOCK, Q_BLOCK + WINDOW, axis=1)
        pos_w = blk * Q_BLOCK - WINDOW + jnp.arange(Q_BLOCK + WINDOW)
        dist_w = t[:, None] - pos_w[None, :]
        mask_w = (dist_w >= 0) & (dist_w < WINDOW) & (pos_w[None, :] >= 0)
        s_w = jnp.einsum('bqgrd,bkgd->bgrqk', qb, k_blk).astype(f32) - slopes[:, :, None, None] * dist_w.astype(f32)
        p_w = masked_softmax(s_w, mask_w)
        o_w = jnp.einsum('bgrqk,bkgd->bqgrd', p_w.astype(v_blk.dtype), v_blk)
        out = gb[..., 0:1] * o_c + gb[..., 1:2] * o_s + gb[..., 2:3] * o_w
        return out.astype(q.dtype)

    out = lax.map(block_fn, (q_blocks, g_blocks, jnp.arange(n_qb)))
    return out.swapaxes(0, 1).reshape(B, S, H * dh)


def causal_conv(x, w, b):
    K = w.shape[0]
    S = x.shape[1]
    xp = jnp.pad(x, ((0, 0), (K - 1, 0), (0, 0)))
    y = b
    for i in range(K):
        y = y + xp[:, i:i + S] * w[i]
    return y


def mlstm(q, k, v, o_pre, i_pre, f_pre, norm_g):
    B, S, _ = q.shape
    H, d, L = MLSTM_HEADS, MLSTM_HEAD_DIM, MLSTM_CHUNK
    nc = S // L
    f32 = jnp.float32

    def to_chunks(a):
        return a.astype(f32).reshape(B, nc, L, H, d).transpose(1, 0, 3, 2, 4)

    def gate_chunks(a):
        return a.astype(f32).reshape(B, nc, L, H).transpose(1, 0, 3, 2)

    qc = to_chunks(q)
    kc = to_chunks(k) * (d ** -0.5)
    vc = to_chunks(v)
    lf = jax.nn.log_sigmoid(gate_chunks(f_pre))
    ig = gate_chunks(i_pre)
    causal = jnp.tril(jnp.ones((L, L), dtype=bool))

    def step(carry, inp):
        C, n, m = carry
        qq, kk, vv, lf_c, ig_c = inp
        a = jnp.cumsum(lf_c, axis=-1)
        log_d = a[..., :, None] - a[..., None, :] + ig_c[..., None, :]
        log_d = jnp.where(causal, log_d, -jnp.inf)
        m_inter = a + m[..., None]
        m_t = jnp.maximum(m_inter, jnp.max(log_d, axis=-1))
        d_mat = jnp.exp(log_d - m_t[..., None])
        inter = jnp.exp(m_inter - m_t)
        s_qk = jnp.einsum('bhjd,bhsd->bhjs', qq, kk) * d_mat
        num = inter[..., None] * jnp.einsum('bhed,bhjd->bhje', C, qq) + jnp.einsum('bhjs,bhse->bhje', s_qk, vv)
        den = inter * jnp.einsum('bhd,bhjd->bhj', n, qq) + jnp.sum(s_qk, axis=-1)
        h = num / jnp.maximum(jnp.abs(den), jnp.exp(-m_t))[..., None]
        a_last = a[..., -1]
        log_w = a_last[..., None] - a + ig_c
        m_new = jnp.maximum(a_last + m, jnp.max(log_w, axis=-1))
        w = jnp.exp(log_w - m_new[..., None])
        decay = jnp.exp(a_last + m - m_new)
        C_new = decay[..., None, None] * C + jnp.einsum('bhse,bhsd->bhed', w[..., None] * vv, kk)
        n_new = decay[..., None] * n + jnp.einsum('bhs,bhsd->bhd', w, kk)
        return (C_new, n_new, m_new), h

    init = (jnp.zeros((B, H, d, d), f32), jnp.zeros((B, H, d), f32), jnp.zeros((B, H), f32))
    _, h = lax.scan(step, init, (qc, kc, vc, lf, ig))
    h = h.transpose(1, 0, 3, 2, 4).reshape(B, S, H * d)
    h = jax.nn.sigmoid(o_pre.astype(f32)) * h
    hh = h.reshape(B, S, H, d)
    hh = hh * lax.rsqrt(jnp.mean(hh * hh, axis=-1, keepdims=True) + EPS)
    return (hh.reshape(B, S, H * d) * norm_g.astype(f32)).astype(q.dtype)


def hybrid_mixer(h, w_in, b_in, cmp_pe, cmp_w1, cmp_w2, conv_w, conv_b, mlstm_norm_g, w_out):
    B, S, _ = h.shape
    proj = h @ w_in + b_in
    q_n, kv_n, gate_n, qk_m, v_m, o_m, i_m, f_m = jnp.split(proj, _split_points(), axis=-1)
    y_nsa = nsa_attention(q_n.reshape(B, S, NSA_HEADS, NSA_HEAD_DIM),
                          kv_n.reshape(B, S, 2 * NSA_BRANCHES, NSA_KV_HEADS, NSA_HEAD_DIM),
                          gate_n, cmp_pe, cmp_w1, cmp_w2)
    qk_m = jax.nn.silu(causal_conv(qk_m, conv_w, conv_b))
    q_m, k_m = jnp.split(qk_m, 2, axis=-1)
    y_ml = mlstm(q_m, k_m, v_m, o_m, i_m, f_m, mlstm_norm_g)
    return jnp.concatenate([y_nsa, y_ml], axis=-1) @ w_out


def swiglu(h, wg, wu, wd):
    return (jax.nn.silu(h @ wg) * (h @ wu)) @ wd


def moe_swiglu(h, router_w, w_gate, w_up, w_down):
    B, S, D = h.shape
    N = B * S
    xf = h.reshape(N, D)
    logits = (xf @ router_w).astype(jnp.float32)
    top_val, top_idx = lax.top_k(logits, TOP_K)
    weights = jax.nn.softmax(top_val, axis=-1)
    e_flat = top_idx.reshape(-1)
    tok_flat = jnp.repeat(jnp.arange(N), TOP_K)
    w_flat = weights.reshape(-1)
    order = jnp.argsort(e_flat)
    e_sorted = e_flat[order]
    counts = jnp.bincount(e_flat, length=N_EXPERTS)
    starts = jnp.cumsum(counts) - counts
    padded = (counts + MOE_BLOCK - 1) // MOE_BLOCK * MOE_BLOCK
    pad_ends = jnp.cumsum(padded)
    pad_starts = pad_ends - padded
    dest = pad_starts[e_sorted] + (jnp.arange(N * TOP_K) - starts[e_sorted])
    n_rows = ((N * TOP_K + MOE_BLOCK - 1) // MOE_BLOCK + N_EXPERTS) * MOE_BLOCK
    row_tok = jnp.zeros((n_rows,), jnp.int32).at[dest].set(tok_flat[order])
    row_w = jnp.zeros((n_rows,), jnp.float32).at[dest].set(w_flat[order])
    n_blocks = n_rows // MOE_BLOCK
    blk_expert = jnp.minimum(jnp.searchsorted(pad_ends, jnp.arange(n_blocks) * MOE_BLOCK, side='right'), N_EXPERTS - 1)

    def expert_block(args):
        toks, e = args
        xb = xf[toks]
        return (jax.nn.silu(xb @ w_gate[e]) * (xb @ w_up[e])) @ w_down[e]

    y = lax.map(expert_block, (row_tok.reshape(n_blocks, MOE_BLOCK), blk_expert))
    y = y.reshape(n_rows, D) * row_w[:, None].astype(y.dtype)
    out = jnp.zeros((N, D), h.dtype).at[row_tok].add(y)
    return out.reshape(B, S, D)


def setup_inputs(seed: int = 0) -> dict:
    key = jax.random.key(seed)
    ks = jax.random.split(key, 24)
    f32 = jnp.float32

    def nrm(k, shape, scale):
        return jax.random.normal(k, shape, f32) * scale

    x = nrm(ks[0], (BATCH, SEQ, D_MODEL), 1.0)
    c = nrm(ks[1], (BATCH, D_MODEL), 1.0)
    ada_w = nrm(ks[2], (DEPTH, D_MODEL, 6 * D_MODEL), 0.5 * D_MODEL ** -0.5)
    ada_b = nrm(ks[3], (DEPTH, 6 * D_MODEL), 0.02)
    norm_mix_g = 1.0 + nrm(ks[4], (DEPTH, D_MODEL), 0.05)
    norm_ffn_g = 1.0 + nrm(ks[5], (DEPTH, D_MODEL), 0.05)
    w_in = nrm(ks[6], (DEPTH, D_MODEL, IN_COLS), D_MODEL ** -0.5)
    b_in = nrm(ks[7], (DEPTH, IN_COLS), 0.02)
    b_in = b_in.at[:, -MLSTM_HEADS:].add(jnp.linspace(3.0, 6.0, MLSTM_HEADS, dtype=f32))
    cmp_pe = nrm(ks[8], (DEPTH, 2, CMP_LEN, NSA_HEAD_DIM), 0.02)
    cmp_w1 = nrm(ks[9], (DEPTH, 2, CMP_LEN * NSA_HEAD_DIM, CMP_HIDDEN), (CMP_LEN * NSA_HEAD_DIM) ** -0.5)
    cmp_w2 = nrm(ks[10], (DEPTH, 2, CMP_HIDDEN, NSA_HEAD_DIM), CMP_HIDDEN ** -0.5)
    conv_w = nrm(ks[11], (DEPTH, CONV_WIDTH, 2 * MLSTM_WIDTH), CONV_WIDTH ** -0.5)
    conv_b = nrm(ks[12], (DEPTH, 2 * MLSTM_WIDTH), 0.02)
    mlstm_norm_g = 1.0 + nrm(ks[13], (DEPTH, MLSTM_WIDTH), 0.05)
    w_out = nrm(ks[14], (DEPTH, MIX_WIDTH, D_MODEL), MIX_WIDTH ** -0.5)
    ffn_w_gate = nrm(ks[15], (N_DENSE_LAYERS, D_MODEL, D_FF), D_MODEL ** -0.5)
    ffn_w_up = nrm(ks[16], (N_DENSE_LAYERS, D_MODEL, D_FF), D_MODEL ** -0.5)
    ffn_w_down = nrm(ks[17], (N_DENSE_LAYERS, D_FF, D_MODEL), D_FF ** -0.5)
    router_w = nrm(ks[18], (N_MOE_LAYERS, D_MODEL, N_EXPERTS), D_MODEL ** -0.5)
    moe_w_gate = nrm(ks[19], (N_MOE_LAYERS, N_EXPERTS, D_MODEL, D_FF_EXPERT), D_MODEL ** -0.5)
    moe_w_up = nrm(ks[20], (N_MOE_LAYERS, N_EXPERTS, D_MODEL, D_FF_EXPERT), D_MODEL ** -0.5)
    moe_w_down = nrm(ks[21], (N_MOE_LAYERS, N_EXPERTS, D_FF_EXPERT, D_MODEL), D_FF_EXPERT ** -0.5)
    final_norm_g = 1.0 + nrm(ks[22], (D_MODEL,), 0.05)
    return {'x': x, 'c': c, 'ada_w': ada_w, 'ada_b': ada_b, 'norm_mix_g': norm_mix_g,
            'norm_ffn_g': norm_ffn_g, 'w_in': w_in, 'b_in': b_in, 'cmp_pe': cmp_pe,
            'cmp_w1': cmp_w1, 'cmp_w2': cmp_w2, 'conv_w': conv_w, 'conv_b': conv_b,
            'mlstm_norm_g': mlstm_norm_g, 'w_out': w_out, 'ffn_w_gate': ffn_w_gate,
            'ffn_w_up': ffn_w_up, 'ffn_w_down': ffn_w_down, 'router_w': router_w,
            'moe_w_gate': moe_w_gate, 'moe_w_up': moe_w_up, 'moe_w_down': moe_w_down,
            'final_norm_g': final_norm_g}


def reference(x, c, ada_w, ada_b, norm_mix_g, norm_ffn_g, w_in, b_in, cmp_pe, cmp_w1, cmp_w2,
              conv_w, conv_b, mlstm_norm_g, w_out, ffn_w_gate, ffn_w_up, ffn_w_down, router_w,
              moe_w_gate, moe_w_up, moe_w_down, final_norm_g):
    c_act = jax.nn.silu(c)
    for l in range(DEPTH):
        mod = (c_act @ ada_w[l] + ada_b[l])[:, None, :]
        sh1, sc1, g1, sh2, sc2, g2 = jnp.split(mod, 6, axis=-1)
        h = rmsnorm(x, norm_mix_g[l]) * (1.0 + sc1) + sh1
        x = x + g1 * hybrid_mixer(h, w_in[l], b_in[l], cmp_pe[l], cmp_w1[l], cmp_w2[l],
                                  conv_w[l], conv_b[l], mlstm_norm_g[l], w_out[l])
        h = rmsnorm(x, norm_ffn_g[l]) * (1.0 + sc2) + sh2
        if l % 2 == 0:
            i = l // 2
            y = swiglu(h, ffn_w_gate[i], ffn_w_up[i], ffn_w_down[i])
        else:
            i = l // 2
            y = moe_swiglu(h, router_w[i], moe_w_gate[i], moe_w_up[i], moe_w_down[i])
        x = x + g2 * y
    return rmsnorm(x, final_norm_g)
```

```cpp
#include <hip/hip_runtime.h>
#include <hip/hip_cooperative_groups.h>
#include <cstdio>
#include <cstdint>
namespace cg = cooperative_groups;
namespace pg8 {
#define PG8_LAS __attribute__((address_space(3)))
typedef unsigned short bf16_t;
typedef short bf16x8 __attribute__((ext_vector_type(8)));
typedef float f32x4 __attribute__((ext_vector_type(4)));
typedef unsigned u32x4 __attribute__((ext_vector_type(4)));
constexpr int BM = 256, BK = 64, HALF = 128, HTB = HALF * BK * 2  , STAGE_BYTES = 8 * HTB, NXCD = 8, WGM = 8;

__host__ __device__ __forceinline__ int lds_byte(int r, int c) { const int st = (r >> 4) * 2 + (c >> 5), rr = r & 15, cc = c & 31, ob = rr * 64 + cc * 2; return st * 1024 + (ob ^ (((ob >> 9) & 1) << 5)); }
__host__ __device__ __forceinline__ void stage_rc(int b, int& R, int& C) { const int st = b / 1024, sb = b % 1024, swz = sb ^ (((sb >> 9) & 1) << 5); R = (st >> 1) * 16 + swz / 64; C = (st & 1) * 32 + (swz % 64) / 2; }
__host__ __device__ __forceinline__ int perm32(int rho) { const int n = rho >> 4, i = rho & 15; return 8 * (i >> 2) + 4 * n + (i & 3); }

struct Unit { int pm, pn, e, koff, aux; };
struct Gemm { const bf16_t* A; const bf16_t* Bt; int M, N, K; size_t estride; int ld; };
struct StaticOrder {
    int nM, nN, nwg, G, c;
    __host__ __device__ void init(int M, int N, int G_, int c_) { nM = M / BM; nN = N / BM; nwg = nM * nN; G = G_; c = c_; }
    __host__ __device__ bool next(int i, Unit& u) const {
        const long L = (long)i * G + c; if (L >= nwg) return false;
        int wgid = (int)L; { const int q = nwg / NXCD, r = nwg % NXCD, xcd = wgid % NXCD, off = wgid / NXCD; wgid = (xcd < r ? xcd * (q + 1) : r * (q + 1) + (xcd - r) * q) + off; }
        const int nig = WGM * nN, gid = wgid / nig, fm = gid * WGM, gsz = (nM - fm) < WGM ? (nM - fm) : WGM;
        u.pm = fm + ((wgid % nig) % gsz); u.pn = (wgid % nig) / gsz; u.e = 0; u.koff = 0; u.aux = 0; return true;
    }
    __device__ __forceinline__ void a_ready(const Unit&) const {}
    __device__ __forceinline__ void done(const Unit&) const {}
};

__device__ __forceinline__ unsigned cvt_pk_bf16(float lo, float hi) { unsigned r; asm volatile("v_cvt_pk_bf16_f32 %0, %1, %2" : "=v"(r) : "v"(lo), "v"(hi)); return r; }
typedef float f32x2 __attribute__((ext_vector_type(2)));
template <class Epi, class Sched, bool ALIGN_EPI = false, bool SP2 = false>
__device__ __forceinline__ void gemm_phase(PG8_LAS unsigned char* lds, const Gemm g, const Sched& S, const Epi& E, int tid_) {
        const int tid = tid_, wid = __builtin_amdgcn_readfirstlane(tid >> 6), lane = tid & 63, wr = wid >> 2, wc = wid & 3, fr = lane & 15, fq = lane >> 4;
    const int K = g.K, nt = K / BK;
    unsigned voffA[2], voffB[2];
#pragma unroll
    for (int i = 0; i < 2; ++i) { int R, C; stage_rc(tid * 16 + i * 8192, R, C); const int Rb = Epi::PERM ? ((R & ~31) + perm32(R & 31)) : R;
        voffA[i] = (unsigned)(R * g.ld + C) * 2u; voffB[i] = (unsigned)(Rb * g.ld + C) * 2u; }
    const size_t kstep = (size_t)(BK * 2);
    const size_t hstep = (size_t)HALF * g.ld * 2;
    const size_t tstep = 2 * hstep;
    const unsigned ldsw = (unsigned)wid * 1024u;
    const int aoff = lds_byte(wr * 64 + fr, fq * 8), boff = lds_byte(wc * 32 + fr, fq * 8);
#define PG8_SA(b, h) (((b) * 2 + (h)) * HTB)
#define PG8_SB(b, h) ((4 + (b) * 2 + (h)) * HTB)
#define PG8_STAGE(bufoff, gbase, voff) do { _Pragma("unroll") for (int _i = 0; _i < 2; ++_i) \
        __builtin_amdgcn_global_load_lds((const unsigned*)((const char*)(gbase) + (voff)[_i]), (PG8_LAS unsigned*)(lds + (bufoff) + ldsw + _i * 8192), 16, 0, 0); } while (0)
#define PG8_LDA(dst, b, h) do { _Pragma("unroll") for (int m = 0; m < 4; ++m) _Pragma("unroll") for (int k = 0; k < 2; ++k) dst[m][k] = *(const PG8_LAS bf16x8*)(lds + PG8_SA(b, h) + aoff + m * 2048 + k * 1024); } while (0)
#define PG8_LDB(dst, b, h) do { _Pragma("unroll") for (int n = 0; n < 2; ++n) _Pragma("unroll") for (int k = 0; k < 2; ++k) dst[n][k] = *(const PG8_LAS bf16x8*)(lds + PG8_SB(b, h) + boff + n * 2048 + k * 1024); } while (0)
#define PG8_MMA(ai, bj, At, Bt) do { __builtin_amdgcn_s_setprio(1); _Pragma("unroll") for (int m = 0; m < 4; ++m) _Pragma("unroll") for (int n = 0; n < 2; ++n) _Pragma("unroll") for (int k = 0; k < 2; ++k) \
        acc[ai][bj][m][n] = __builtin_amdgcn_mfma_f32_16x16x32_bf16(Bt[n][k], At[m][k], acc[ai][bj][m][n], 0, 0, 0); __builtin_amdgcn_s_setprio(0); } while (0)
#define PG8_WAIT_V(n) asm volatile("s_waitcnt vmcnt(" #n ")" ::: "memory")
#define PG8_WAIT_L(n) asm volatile("s_waitcnt lgkmcnt(" #n ")" ::: "memory")
#define PG8_BAR __builtin_amdgcn_s_barrier()
#define PG8_SCHED __builtin_amdgcn_sched_barrier(0)
    Unit cur, nxt; int ui = 0;
    if (!S.next(0, cur)) return;
    f32x4 acc[2][2][4][2];
#pragma unroll
    for (int a = 0; a < 2; ++a)
#pragma unroll
        for (int b = 0; b < 2; ++b)
#pragma unroll
            for (int m = 0; m < 4; ++m)
#pragma unroll
                for (int n = 0; n < 2; ++n) acc[a][b][m][n] = (f32x4){0.f, 0.f, 0.f, 0.f};
    bf16x8 At[4][2], B0[2][2], B1[2][2];
    const char* cA = (const char*)g.A + (size_t)cur.pm * tstep + (size_t)cur.koff * 2; const char* cB = (const char*)g.Bt + (size_t)cur.pn * tstep + (size_t)cur.e * g.estride + (size_t)cur.koff * 2;
    S.a_ready(cur);
    if constexpr (SP2) {
        PG8_STAGE(PG8_SB(0, 0), cB, voffB); PG8_STAGE(PG8_SB(0, 1), cB + hstep, voffB); PG8_STAGE(PG8_SA(0, 0), cA, voffA); PG8_STAGE(PG8_SA(0, 1), cA + hstep, voffA);
        if (wr == 1) PG8_BAR;
        PG8_WAIT_V(2); PG8_BAR;
        PG8_STAGE(PG8_SB(1, 0), cB + kstep, voffB); PG8_STAGE(PG8_SA(1, 0), cA + kstep, voffA); PG8_STAGE(PG8_SB(1, 1), cB + hstep + kstep, voffB);
        PG8_WAIT_V(6); PG8_BAR;
    } else {
        PG8_STAGE(PG8_SB(0, 0), cB, voffB); PG8_STAGE(PG8_SA(0, 0), cA, voffA); PG8_STAGE(PG8_SB(0, 1), cB + hstep, voffB); PG8_STAGE(PG8_SA(0, 1), cA + hstep, voffA);
        if (wr == 1) PG8_BAR;
        PG8_WAIT_V(4); PG8_BAR;
        PG8_STAGE(PG8_SB(1, 0), cB + kstep, voffB); PG8_STAGE(PG8_SA(1, 0), cA + kstep, voffA); PG8_STAGE(PG8_SB(1, 1), cB + hstep + kstep, voffB);
        PG8_WAIT_V(6); PG8_BAR;
    }
    for (;;) {
        const bool has_next = S.next(ui + 1, nxt);
        const char* nA = has_next ? (const char*)g.A + (size_t)nxt.pm * tstep + (size_t)nxt.koff * 2 : cA; const char* nB = has_next ? (const char*)g.Bt + (size_t)nxt.pn * tstep + (size_t)nxt.e * g.estride + (size_t)nxt.koff * 2 : cB;
        for (int t = 0; t < nt; t += 2) {
            const bool last = (t == nt - 2);
            const char* a1 = cA + (size_t)(t + 1) * kstep;
            const char* a2 = last ? nA : cA + (size_t)(t + 2) * kstep; const char* b2 = last ? nB : cB + (size_t)(t + 2) * kstep;
            const char* a3 = a2 + kstep; const char* b3 = b2 + kstep;
            if (last && has_next) S.a_ready(nxt);
            if constexpr (SP2) {
            PG8_LDB(B0, 0, 0); PG8_LDB(B1, 0, 1); PG8_SCHED; PG8_LDA(At, 0, 0); PG8_STAGE(PG8_SA(1, 1), a1 + hstep, voffA);
            PG8_WAIT_V(8); PG8_WAIT_L(0); PG8_BAR; PG8_MMA(0, 0, At, B0); PG8_MMA(0, 1, At, B1); PG8_BAR; PG8_SCHED;
            PG8_LDA(At, 0, 1); PG8_STAGE(PG8_SB(0, 0), b2, voffB); PG8_STAGE(PG8_SB(0, 1), b2 + hstep, voffB); PG8_STAGE(PG8_SA(0, 0), a2, voffA);
            PG8_WAIT_V(8); PG8_WAIT_L(0); PG8_BAR; PG8_MMA(1, 0, At, B0); PG8_MMA(1, 1, At, B1); PG8_BAR; PG8_SCHED;
            PG8_LDB(B0, 1, 0); PG8_LDB(B1, 1, 1); PG8_SCHED; PG8_LDA(At, 1, 0); PG8_STAGE(PG8_SA(0, 1), a2 + hstep, voffA);
            PG8_WAIT_V(8); PG8_WAIT_L(0); PG8_BAR; PG8_MMA(0, 0, At, B0); PG8_MMA(0, 1, At, B1); PG8_BAR; PG8_SCHED;
            PG8_LDA(At, 1, 1); PG8_STAGE(PG8_SB(1, 0), b3, voffB); PG8_STAGE(PG8_SB(1, 1), b3 + hstep, voffB); PG8_STAGE(PG8_SA(1, 0), a3, voffA);
            PG8_WAIT_V(8); PG8_WAIT_L(0); PG8_BAR; PG8_MMA(1, 0, At, B0); PG8_MMA(1, 1, At, B1); PG8_BAR; PG8_SCHED;
            } else {
            PG8_LDB(B0, 0, 0); PG8_SCHED; PG8_LDA(At, 0, 0); PG8_STAGE(PG8_SA(1, 1), a1 + hstep, voffA);
            PG8_WAIT_L(8); PG8_BAR; PG8_WAIT_L(0); PG8_MMA(0, 0, At, B0); PG8_BAR; PG8_SCHED;
            PG8_LDB(B1, 0, 1); PG8_STAGE(PG8_SB(0, 0), b2, voffB);
            PG8_BAR; PG8_WAIT_L(0); PG8_MMA(0, 1, At, B1); PG8_BAR;
            PG8_LDA(At, 0, 1); PG8_STAGE(PG8_SA(0, 0), a2, voffA);
            PG8_BAR; PG8_WAIT_L(0); PG8_MMA(1, 0, At, B0); PG8_BAR; PG8_SCHED;
            PG8_STAGE(PG8_SB(0, 1), b2 + hstep, voffB);
            PG8_WAIT_V(6); PG8_BAR; PG8_MMA(1, 1, At, B1); PG8_BAR;
            PG8_LDB(B0, 1, 0); PG8_SCHED; PG8_LDA(At, 1, 0); PG8_STAGE(PG8_SA(0, 1), a2 + hstep, voffA);
            PG8_WAIT_L(8); PG8_BAR; PG8_WAIT_L(0); PG8_MMA(0, 0, At, B0); PG8_BAR; PG8_SCHED;
            PG8_LDB(B1, 1, 1); PG8_STAGE(PG8_SB(1, 0), b3, voffB);
            PG8_BAR; PG8_WAIT_L(0); PG8_MMA(0, 1, At, B1); PG8_BAR;
            PG8_LDA(At, 1, 1); PG8_STAGE(PG8_SA(1, 0), a3, voffA);
            PG8_BAR; PG8_WAIT_L(0); PG8_MMA(1, 0, At, B0); PG8_BAR; PG8_SCHED;
            PG8_STAGE(PG8_SB(1, 1), b3 + hstep, voffB);
            PG8_WAIT_V(6); PG8_BAR; PG8_MMA(1, 1, At, B1); PG8_BAR;
            }
        }
        if constexpr (ALIGN_EPI) { if (wr == 0) PG8_BAR; }
        if constexpr (!Epi::AFTER_DRAIN) { E(acc, cur, wr, wc, fr, fq); S.done(cur); }
        if (!has_next) break;
#pragma unroll
        for (int a = 0; a < 2; ++a)
#pragma unroll
            for (int b = 0; b < 2; ++b)
#pragma unroll
                for (int m = 0; m < 4; ++m)
#pragma unroll
                    for (int n = 0; n < 2; ++n) acc[a][b][m][n] = (f32x4){0.f, 0.f, 0.f, 0.f};
        cur = nxt; cA = nA; cB = nB; ++ui;
        if constexpr (ALIGN_EPI) { if (wr == 1) PG8_BAR; }
    }
    PG8_WAIT_V(0);
    if constexpr (!ALIGN_EPI) { if (wr == 0) PG8_BAR; }
    PG8_BAR;
    if constexpr (Epi::AFTER_DRAIN) { E.fused(acc, cur, wr, wc, fr, fq, lds, wid, lane); S.done(cur); }
#undef PG8_SA
#undef PG8_SB
#undef PG8_STAGE
#undef PG8_LDA
#undef PG8_LDB
#undef PG8_MMA
#undef PG8_WAIT_V
#undef PG8_WAIT_L
#undef PG8_BAR
#undef PG8_SCHED
}
}

#ifndef MK_PER_PHASE
#define MK_PER_PHASE 0
#endif
typedef unsigned short bf16;
typedef float f32x4 __attribute__((ext_vector_type(4)));
typedef float f32x16 __attribute__((ext_vector_type(16)));
typedef short bf16x8 __attribute__((ext_vector_type(8)));
typedef unsigned u32x4 __attribute__((ext_vector_type(4)));
typedef unsigned u32x2 __attribute__((ext_vector_type(2)));

constexpr int NB = 4, SEQ = 4096, DM = 1024, M = NB * SEQ;
constexpr int NPROJ = 3584, PLD = 3328;
constexpr int C_QN = 0, C_KV = 512, C_QKM = 1280, C_VM = 2304, C_OM = 2816;
constexpr int IN_COLS = 3360;
constexpr int DFF = 2816, DFFE = 3584, NE = 8, MAXR = 34816;
constexpr int NWAVES = 8, NTHR = 512;
constexpr float EPSN = 1e-6f;
constexpr float LOG2E = 1.4426950408889634f;

constexpr size_t MiB = 1u << 20;
constexpr size_t WS_CTL = 0, CTL_ZERO_BYTES = 64 * 1024;
constexpr size_t WS_MODP = 1 * MiB;
constexpr size_t WS_C1P = WS_MODP + 1572864;
constexpr size_t WS_BIASP = WS_C1P + 32768;
constexpr size_t WS_TOPI = 3 * MiB;
constexpr size_t WS_TOPW = WS_TOPI + 131072;
constexpr size_t WS_DEST = WS_TOPW + 131072;
constexpr size_t WS_RWT = WS_DEST + 131072 + 65536;
constexpr size_t WS_MODF = WS_DEST + 131072 + 65536 + 32768;
constexpr size_t WS_WCNT = WS_DEST + 131072;
constexpr size_t WS_MOE_GU = 4 * MiB;
constexpr size_t WS_YG = WS_MOE_GU;
constexpr size_t WS_XG = 116 * MiB;
constexpr size_t WS_ARENA = 184 * MiB;
constexpr size_t WS_HG = WS_ARENA;
constexpr size_t WS_XN = WS_ARENA;
constexpr size_t WS_PROJ = WS_ARENA + 32 * MiB;
constexpr size_t WS_HB = WS_PROJ;
constexpr size_t WS_GATES = WS_ARENA + 136 * MiB;
constexpr size_t WS_KC = WS_ARENA + 138 * MiB;
constexpr size_t WS_NL = WS_KC + 524288;
constexpr size_t WS_SC = WS_ARENA + 139 * MiB;
constexpr size_t WS_MP = WS_SC + 65536;
constexpr size_t WS_LC = WS_ARENA + 140 * MiB;
constexpr size_t WS_CP = WS_ARENA + 204 * MiB;
constexpr size_t WS_NP = WS_ARENA + 236 * MiB;
constexpr size_t WS_Y = WS_ARENA + 237 * MiB;
constexpr size_t WS_WSMALL = WS_ARENA + 269 * MiB;
constexpr size_t WS_WIN = WS_WSMALL;
constexpr size_t WS_WOUT = WS_WIN + 14 * MiB;
constexpr size_t WS_WGU = WS_WOUT + 4 * MiB;
constexpr size_t WS_WDN = WS_WGU + 11 * MiB;
constexpr size_t WS_W1T = WS_WDN + 5767168;
constexpr size_t WS_END = WS_W1T + 2 * MiB;
constexpr size_t WS_MOE_DN = WS_HG + (size_t)MAXR * DFFE * 2;
static_assert(WS_MOE_DN + (size_t)NE * DM * DFFE * 2 <= WS_END, "MOE_DN fits");
static_assert(WS_YG + (size_t)MAXR * DM * 4 <= WS_ARENA, "YG fits");
static_assert(WS_XG + (size_t)MAXR * DM * 2 <= WS_ARENA, "XG fits");
constexpr int CW_CNT = 0, CW_CUR = 64, CW_BAR = 1024;
constexpr int LDS_BAR_ST = 131072;

constexpr int LDS_BYTES = 147456;

struct Params { const float* in[23]; float* out; unsigned char* ws; int ph_lo, ph_hi, li, pad; };

__device__ __forceinline__ float bf2f(unsigned v) { return __uint_as_float(v << 16); }
__device__ __forceinline__ unsigned f2bf(float f) { unsigned u = __float_as_uint(f); return (u + 0x7fffu + ((u >> 16) & 1u)) >> 16; }
typedef float f32x2_t __attribute__((ext_vector_type(2))); typedef __bf16 bf16x2_t __attribute__((ext_vector_type(2)));
__device__ __forceinline__ unsigned pk2(float lo, float hi) { f32x2_t v = {lo, hi}; bf16x2_t b = __builtin_convertvector(v, bf16x2_t); return __builtin_bit_cast(unsigned, b); }
__device__ __forceinline__ float wave_sum(float v) {
#pragma unroll
    for (int o = 1; o < 64; o <<= 1) v += __shfl_xor(v, o);
    return v;
}
__device__ __forceinline__ float wave_max(float v) {
#pragma unroll
    for (int o = 1; o < 64; o <<= 1) v = fmaxf(v, __shfl_xor(v, o));
    return v;
}
__device__ __forceinline__ float sigmoidf_(float x) { return 1.0f / (1.0f + __expf(-x)); }
__device__ __forceinline__ float siluf_(float x) { return x / (1.0f + __expf(-x)); }
__device__ __forceinline__ float logsigmoidf_(float x) { return fminf(x, 0.f) - log1pf(__expf(-fabsf(x))); }
#define LDS_WAIT() asm volatile("s_waitcnt lgkmcnt(0)" ::: "memory")

__device__ __forceinline__ f32x4 ldu4(const float* ubase, unsigned voffb) { return *(const f32x4*)((const char*)ubase + voffb); }
__device__ __forceinline__ f32x4 mod4u(const float* ada_b, const float* MODP, int l, int b, int ucol, unsigned voffb) {
    f32x4 v = ldu4(ada_b + l * 6144 + ucol, voffb);
#pragma unroll
    for (int kc = 0; kc < 8; ++kc) v += ldu4(MODP + (size_t)((l * 8 + kc) * 4 + b) * 6144 + ucol, voffb);
    return v;
}
__device__ __forceinline__ f32x4 mod4(const float* ada_b, const float* MODP, int l, int b, int col) {
    f32x4 v = *(const f32x4*)(ada_b + l * 6144 + col);
#pragma unroll
    for (int kc = 0; kc < 8; ++kc) v += *(const f32x4*)(MODP + (size_t)((l * 8 + kc) * 4 + b) * 6144 + col);
    return v;
}

struct EpiProj {
    static constexpr bool PERM = false, AFTER_DRAIN = false;
    bf16* PROJ; float* GATES; const float* bias;
    __device__ __forceinline__ void operator()(const f32x4 (&acc)[2][2][4][2], const pg8::Unit& u, int wr, int wc, int fr, int fq) const {
        const int row0 = u.pm * 256 + wr * 64 + fr, col0 = u.pn * 256 + wc * 32 + 4 * fq;
        f32x4 bv[2][2];
#pragma unroll
        for (int bj = 0; bj < 2; ++bj)
#pragma unroll
            for (int n = 0; n < 2; ++n) bv[bj][n] = *(const f32x4*)(bias + col0 + bj * 128 + n * 16);
        if (u.pn < 13) {
#pragma unroll
            for (int ai = 0; ai < 2; ++ai)
#pragma unroll
                for (int m = 0; m < 4; ++m) { bf16* rowp = PROJ + (size_t)(row0 + ai * 128 + m * 16) * PLD + col0;
#pragma unroll
                    for (int bj = 0; bj < 2; ++bj)
#pragma unroll
                        for (int n = 0; n < 2; ++n) { const f32x4 v = acc[ai][bj][m][n] + bv[bj][n]; u32x2 w; w.x = pk2(v[0], v[1]); w.y = pk2(v[2], v[3]); *(u32x2*)(rowp + bj * 128 + n * 16) = w; } }
        } else if (wc == 0) {
#pragma unroll
            for (int ai = 0; ai < 2; ++ai)
#pragma unroll
                for (int m = 0; m < 4; ++m) { float* rowp = GATES + (size_t)(row0 + ai * 128 + m * 16) * 32 + 4 * fq;
#pragma unroll
                    for (int n = 0; n < 2; ++n) *(f32x4*)(rowp + n * 16) = acc[ai][0][m][n] + bv[0][n]; }
        }
    }
};
struct EpiRes {
    static constexpr bool PERM = false, AFTER_DRAIN = false;
    const float* xin; float* xout; const float* MODF; int l, goff;
    __device__ __forceinline__ void operator()(const f32x4 (&acc)[2][2][4][2], const pg8::Unit& u, int wr, int wc, int fr, int fq) const {
        const int row0 = u.pm * 256 + wr * 64 + fr, col0 = u.pn * 256 + wc * 32 + 4 * fq, b = (u.pm * 256) >> 12;
        f32x4 gv[2][2];
#pragma unroll
        for (int bj = 0; bj < 2; ++bj)
#pragma unroll
            for (int n = 0; n < 2; ++n) gv[bj][n] = *(const f32x4*)(MODF + (size_t)(l * 4 + b) * 6144 + goff + col0 + bj * 128 + n * 16);
#pragma unroll
        for (int ai = 0; ai < 2; ++ai)
#pragma unroll
            for (int m = 0; m < 4; ++m) { const size_t off = (size_t)(row0 + ai * 128 + m * 16) * DM + col0;
#pragma unroll
                for (int bj = 0; bj < 2; ++bj)
#pragma unroll
                    for (int n = 0; n < 2; ++n) { const f32x4 x = *(const f32x4*)(xin + off + bj * 128 + n * 16); *(f32x4*)(xout + off + bj * 128 + n * 16) = x + gv[bj][n] * acc[ai][bj][m][n]; } }
    }
};
struct EpiSwiglu {
    static constexpr bool PERM = false, AFTER_DRAIN = false;
    bf16* H; int ldh;
    __device__ __forceinline__ void operator()(const f32x4 (&acc)[2][2][4][2], const pg8::Unit& u, int wr, int wc, int fr, int fq) const {
        const int row0 = u.pm * 256 + wr * 64 + fr, hc0 = u.pn * 128 + wc * 32 + 4 * fq;
#pragma unroll
        for (int ai = 0; ai < 2; ++ai)
#pragma unroll
            for (int m = 0; m < 4; ++m) { bf16* rowp = H + (size_t)(row0 + ai * 128 + m * 16) * ldh + hc0;
#pragma unroll
                for (int n = 0; n < 2; ++n) { const f32x4 g = acc[ai][0][m][n], uu = acc[ai][1][m][n]; f32x4 v;
#pragma unroll
                    for (int k = 0; k < 4; ++k) v[k] = siluf_(g[k]) * uu[k];
                    u32x2 w; w.x = pk2(v[0], v[1]); w.y = pk2(v[2], v[3]); *(u32x2*)(rowp + n * 16) = w; } }
    }
};
struct EpiF32 {
    static constexpr bool PERM = false, AFTER_DRAIN = false;
    float* O;
    __device__ __forceinline__ void operator()(const f32x4 (&acc)[2][2][4][2], const pg8::Unit& u, int wr, int wc, int fr, int fq) const {
        const int row0 = u.pm * 256 + wr * 64 + fr, col0 = u.pn * 256 + wc * 32 + 4 * fq;
#pragma unroll
        for (int ai = 0; ai < 2; ++ai)
#pragma unroll
            for (int m = 0; m < 4; ++m) { const size_t off = (size_t)(row0 + ai * 128 + m * 16) * DM + col0;
#pragma unroll
                for (int bj = 0; bj < 2; ++bj)
#pragma unroll
                    for (int n = 0; n < 2; ++n) *(f32x4*)(O + off + bj * 128 + n * 16) = acc[ai][bj][m][n]; }
    }
};
template <int SPLIT> struct MoeOrderT {
    int cum[9]; int nN, G, c, lo, hi, kpart;
    __device__ __forceinline__ void init(const unsigned* cnt, int nN_, int G_, int c_) { nN = nN_; G = G_; c = c_; cum[0] = 0; kpart = 0;
#pragma unroll
        for (int e = 0; e < 8; ++e) cum[e + 1] = cum[e] + (int)((cnt[e] + 255u) >> 8);
        lo = 0; hi = cum[8] * nN; }
    __device__ __forceinline__ int total() const { return cum[8] * nN; }
    __device__ __forceinline__ bool next(int i, pg8::Unit& u) const {
        const int q = i * G + c; if (q >= (hi - lo) * SPLIT) return false;
        const int L = lo + q / SPLIT, ks = q % SPLIT;
        int se = 0, sb = 0, st = 1;
#pragma unroll
        for (int e = 0; e < 8; ++e) { if (L >= cum[e] * nN && L < cum[e + 1] * nN) { se = e; sb = cum[e]; st = cum[e + 1] - cum[e]; } }
        const int local = L - sb * nN; u.pm = sb + local % st; u.pn = local / st; u.e = se; u.koff = ks * kpart; u.aux = q; return true;
    }
    __device__ __forceinline__ void a_ready(const pg8::Unit&) const {}
    __device__ __forceinline__ void done(const pg8::Unit&) const {}
};
typedef MoeOrderT<1> MoeOrder;
struct EpiPart {
    static constexpr bool PERM = false, AFTER_DRAIN = false;
    float* PART;
    __device__ __forceinline__ void operator()(const f32x4 (&acc)[2][2][4][2], const pg8::Unit& u, int wr, int wc, int fr, int fq) const {
        float* base = PART + (size_t)u.aux * 65536 + (size_t)(wr * 64 + fr) * 256 + wc * 32 + 4 * fq;
#pragma unroll
        for (int ai = 0; ai < 2; ++ai)
#pragma unroll
            for (int m = 0; m < 4; ++m)
#pragma unroll
                for (int bj = 0; bj < 2; ++bj)
#pragma unroll
                    for (int n = 0; n < 2; ++n) *(f32x4*)(base + (size_t)(ai * 128 + m * 16) * 256 + bj * 128 + n * 16) = acc[ai][bj][m][n];
    }
};
constexpr size_t WS_PART = 140 * MiB;
static_assert(WS_YG + (size_t)MAXR * DM * 4 <= WS_PART && WS_PART + (size_t)128 * 65536 * 4 <= WS_ARENA, "PART fits");

__device__ __forceinline__ void conv_item64(const float* W, int ldw, int scol, int k0, bf16* dst, int dpitch, bf16* scr, int lane) {
    const int kq = lane >> 4, n4 = lane & 15;
    f32x4 v[16];
    const float* src = W + (size_t)(k0 + kq) * ldw + (scol >= 0 ? scol : 0);
#pragma unroll
    for (int i = 0; i < 16; ++i) v[i] = *(const f32x4*)(src + (size_t)(4 * i) * ldw);
    if (scol < 0) {
#pragma unroll
        for (int i = 0; i < 16; ++i) v[i] = (f32x4){0.f, 0.f, 0.f, 0.f}; }
#pragma unroll
    for (int i = 0; i < 16; ++i) { const int k = 4 * i + kq; const unsigned p0 = pk2(v[i][0], v[i][1]), p1 = pk2(v[i][2], v[i][3]); bf16* d = scr + (4 * n4) * 72 + k;
        d[0] = (bf16)(p0 & 0xffffu); d[72] = (bf16)(p0 >> 16); d[144] = (bf16)(p1 & 0xffffu); d[216] = (bf16)(p1 >> 16); }
    LDS_WAIT();
    const int c = lane & 7;
#pragma unroll
    for (int j = 0; j < 8; ++j) { const int n = (lane >> 3) + 8 * j; const u32x4 o = *(const u32x4*)(scr + n * 72 + 8 * c); *(u32x4*)(dst + (size_t)n * dpitch + 8 * c) = o; }
    LDS_WAIT();
}
__device__ __forceinline__ int proj_src_col(int n) { return n < 1280 ? n : (n < 3328 ? n + 24 : (n < 3352 ? n - 2048 : (n < 3360 ? n : -1))); }

struct CItem { const float* src; bf16* dst; int ldw, dpitch, zero; };
__device__ __forceinline__ void conv_issue(const CItem& it, f32x4 (&v)[16]) {
#pragma unroll
    for (int i = 0; i < 16; ++i) v[i] = *(const f32x4*)(it.src + (size_t)(4 * i) * it.ldw);
}
__device__ __forceinline__ void conv_zero(f32x4 (&v)[16]) {
#pragma unroll
    for (int i = 0; i < 16; ++i) v[i] = (f32x4){0.f, 0.f, 0.f, 0.f};
}
__device__ __forceinline__ void conv_finish(const CItem& it, f32x4 (&v)[16], bf16* scr, int lane) {
    const int kq = lane >> 4, n4 = lane & 15;
    if (it.zero) {
#pragma unroll
        for (int i = 0; i < 16; ++i) v[i] = (f32x4){0.f, 0.f, 0.f, 0.f}; }
#pragma unroll
    for (int i = 0; i < 16; ++i) { const int k = 4 * i + kq; const unsigned p0 = pk2(v[i][0], v[i][1]), p1 = pk2(v[i][2], v[i][3]); bf16* d = scr + (4 * n4) * 72 + k;
        d[0] = (bf16)(p0 & 0xffffu); d[72] = (bf16)(p0 >> 16); d[144] = (bf16)(p1 & 0xffffu); d[216] = (bf16)(p1 >> 16); }
    LDS_WAIT();
    const int c = lane & 7;
#pragma unroll
    for (int j = 0; j < 8; ++j) { const int n = (lane >> 3) + 8 * j; const u32x4 o = *(const u32x4*)(scr + n * 72 + 8 * c); *(u32x4*)(it.dst + (size_t)n * it.dpitch + 8 * c) = o; }
    LDS_WAIT();
}
__device__ __forceinline__ void citem_make(CItem& it, const float* W, int ldw, int scol, int k0, bf16* dst, int dpitch, int lane) {
    it.src = W + (size_t)(k0 + (lane >> 4)) * ldw + (scol >= 0 ? scol : 0); it.dst = dst; it.ldw = ldw; it.dpitch = dpitch; it.zero = scol < 0;
}
constexpr int MGU_P = 6592;
constexpr int D_WOUT0 = 256, D_WGU = 1408, D_WDN = 704, D_WOUT1 = 256, D_WIN1 = 896, D_W1T1 = 128, D_TOTAL = D_WOUT0 + D_WGU + D_WDN + D_WOUT1 + D_WIN1 + D_W1T1 + MGU_P;
__device__ __forceinline__ bool ditem_decode(const Params& P, int d, int lane, CItem& it) {
    if (d < 0 || d >= D_TOTAL) return false;
    unsigned char* ws = P.ws; const int n4 = 4 * (lane & 15); int r = d;
    if (r < D_WOUT0) { const int kb = r / 16, nb = r % 16; citem_make(it, P.in[14], DM, nb * 64 + n4, kb * 64, (bf16*)(ws + WS_WOUT) + (size_t)(nb * 64) * DM + kb * 64, DM, lane); return true; }
    r -= D_WOUT0;
    if (r < D_WGU) { const int kb = r / 88, nb = r % 88, n0 = nb * 64, t = n0 >> 8, w = n0 & 255; const float* src = (w < 128) ? P.in[15] : P.in[16];
        citem_make(it, src, DFF, t * 128 + (w & 127) + n4, kb * 64, (bf16*)(ws + WS_WGU) + (size_t)n0 * DM + kb * 64, DM, lane); return true; }
    r -= D_WGU;
    if (r < D_WDN) { const int kb = r / 16, nb = r % 16; citem_make(it, P.in[17], DM, nb * 64 + n4, kb * 64, (bf16*)(ws + WS_WDN) + (size_t)(nb * 64) * DFF + kb * 64, DFF, lane); return true; }
    r -= D_WDN;
    if (r < D_WOUT1) { const int kb = r / 16, nb = r % 16; citem_make(it, P.in[14] + (size_t)DM * DM, DM, nb * 64 + n4, kb * 64, (bf16*)(ws + WS_WOUT) + ((size_t)DM + nb * 64) * DM + kb * 64, DM, lane); return true; }
    r -= D_WOUT1;
    if (r < D_WIN1) { const int kb = r / 56, nb = r % 56; citem_make(it, P.in[6] + (size_t)DM * IN_COLS, IN_COLS, proj_src_col(nb * 64 + n4), kb * 64, (bf16*)(ws + WS_WIN) + ((size_t)NPROJ + nb * 64) * DM + kb * 64, DM, lane); return true; }
    r -= D_WIN1;
    if (r < D_W1T1) { const int lj = 2 + r / 64, q = r % 64, kb = q / 2, nb = q % 2; citem_make(it, P.in[9] + (size_t)lj * 2048 * 128, 128, nb * 64 + n4, kb * 64, (bf16*)(ws + WS_W1T) + ((size_t)lj * 128 + nb * 64) * 2048 + kb * 64, 2048, lane); return true; }
    r -= D_W1T1;
    { const int e = r / 1792, q = r % 1792, kb = q / 112, nb = q % 112, n0 = nb * 64, t = n0 >> 8, w = n0 & 255; const float* src = ((w < 128) ? P.in[19] : P.in[20]) + (size_t)e * DM * DFFE;
        citem_make(it, src, DFFE, t * 128 + (w & 127) + n4, kb * 64, (bf16*)(ws + WS_MOE_GU) + ((size_t)e * 7168 + n0) * DM + kb * 64, DM, lane); return true; }
}
constexpr int LDS_DCONV = 57344;

__device__ __forceinline__ void conv_moe_dn_items(const Params& P, bf16* scr, int gw, int NGW, int lane) {
    bf16* dstb = (bf16*)(P.ws + WS_MOE_DN);
    constexpr int NBLK = 16, KBLK = 56, PER_E = NBLK * KBLK;
    for (int it = gw; it < NE * PER_E; it += NGW) { const int e = it / PER_E, r = it % PER_E, kb = r / NBLK, nb = r % NBLK;
        conv_item64(P.in[21] + (size_t)e * DFFE * DM, DM, nb * 64 + 4 * (lane & 15), kb * 64, dstb + ((size_t)e * DM + nb * 64) * DFFE + kb * 64, DFFE, scr, lane); }
}

__device__ __forceinline__ void prologue(const Params& P, unsigned char* lds, int gw, int NGW, int wave, int lane) {
    bf16* scr = (bf16*)(lds + wave * 16384);
    unsigned char* ws = P.ws;
    constexpr int I_WIN = 56 * 16, I_W1T = 2 * 2 * 32;
    constexpr int I_MOD = 2 * 24 * 8, I_C1 = 2 * 2 * 16 * 2, I_BIAS = 112 + 16;
    constexpr int NIT = I_WIN + I_W1T + I_MOD + I_C1 + I_BIAS;
    const int n4 = 4 * (lane & 15);
    for (int it = gw; it < NIT; it += NGW) {
        int r = it;
        if (r < I_MOD) {
            const int l = r / 192, cb = (r % 192) / 8, kc = r % 8, col = cb * 256 + 4 * lane;
            const float* aw = P.in[2] + (size_t)l * DM * 6144; const float* c = P.in[1];
            f32x4 a0 = {0, 0, 0, 0}, a1 = a0, a2 = a0, a3 = a0;
#pragma unroll 8
            for (int k = kc * 128; k < kc * 128 + 128; ++k) { const f32x4 w = *(const f32x4*)(aw + (size_t)k * 6144 + col);
                a0 += siluf_(c[k]) * w; a1 += siluf_(c[DM + k]) * w; a2 += siluf_(c[2 * DM + k]) * w; a3 += siluf_(c[3 * DM + k]) * w; }
            float* o = (float*)(ws + WS_MODP) + (size_t)((l * 8 + kc) * 4) * 6144 + col;
            *(f32x4*)(o) = a0; *(f32x4*)(o + 6144) = a1; *(f32x4*)(o + 2 * 6144) = a2; *(f32x4*)(o + 3 * 6144) = a3;
            continue; }
        r -= I_MOD;
        if (r < I_C1) {
            const int lj = r / 32, kc = (r % 32) / 2, hh = r % 2, hid = hh * 64 + lane;
            const float* pe = P.in[8] + (size_t)lj * 2048; const float* w1 = P.in[9] + (size_t)lj * 2048 * 128;
            float a = 0.f;
#pragma unroll 8
            for (int k = kc * 128; k < kc * 128 + 128; ++k) a += pe[k] * w1[(size_t)k * 128 + hid];
            ((float*)(ws + WS_C1P))[(lj * 16 + kc) * 128 + hid] = a;
            continue; }
        r -= I_C1;
        if (r < I_BIAS) {
            if (r >= 112) { const int col = (r - 112) * 64 + lane; const float* rw = P.in[18] + (size_t)col * 8; float* o = (float*)(ws + WS_RWT) + col;
#pragma unroll
                for (int e = 0; e < 8; ++e) o[e * 1024] = rw[e];
                continue; }
            const int l = r / 56, n = (r % 56) * 64 + lane, s = proj_src_col(n);
            ((float*)(ws + WS_BIASP))[l * NPROJ + n] = s >= 0 ? P.in[7][l * IN_COLS + s] : 0.f;
            continue; }
        r -= I_BIAS;
        if (r < I_WIN) { const int kb = r / 56, nb = r % 56;
            conv_item64(P.in[6], IN_COLS, proj_src_col(nb * 64 + n4), kb * 64, (bf16*)(ws + WS_WIN) + (size_t)(nb * 64) * DM + kb * 64, DM, scr, lane); continue; }
        r -= I_WIN;
        { const int lj = r / 64, q = r % 64, kb = q / 2, nb = q % 2;
            conv_item64(P.in[9] + (size_t)lj * 2048 * 128, 128, nb * 64 + n4, kb * 64, (bf16*)(ws + WS_W1T) + ((size_t)lj * 128 + nb * 64) * 2048 + kb * 64, 2048, scr, lane); }
    }
}
constexpr int MGU_ITEMS = 8 * 112 * 16;
__device__ __forceinline__ void conv_moe_gu_items(const Params& P, bf16* scr, int lo, int hi, int widx, int nw, int lane) {
    const int n4 = 4 * (lane & 15);
    for (int r = lo + widx; r < hi; r += nw) { const int e = r / 1792, q = r % 1792, kb = q / 112, nb = q % 112, n0 = nb * 64, t = n0 >> 8, w = n0 & 255;
        const float* src = ((w < 128) ? P.in[19] : P.in[20]) + (size_t)e * DM * DFFE; const int sc0 = t * 128 + (w & 127);
        conv_item64(src, DFFE, sc0 + n4, kb * 64, (bf16*)(P.ws + WS_MOE_GU) + ((size_t)e * 7168 + n0) * DM + kb * 64, DM, scr, lane); }
}

template <int HF> __device__ __forceinline__ void bfly_reduce(float (&pv)[16], int lane) {
    const bool up = (lane & HF) != 0;
#pragma unroll
    for (int i = 0; i < HF; ++i) { const float keep = up ? pv[i + HF] : pv[i], send = up ? pv[i] : pv[i + HF]; pv[i] = keep + __shfl_xor(send, HF); }
    if constexpr (HF > 1) bfly_reduce<HF / 2>(pv, lane);
}
__device__ __forceinline__ void stage_mod2(const float* ada_b, const float* MODP, int l, int b, int offA, int offB, float* dstA, float* dstB, int tid) {
    const int which = tid >> 8, c4 = (tid & 255) * 4, off = (which ? offB : offA) + c4;
    f32x4 p[9]; p[0] = *(const f32x4*)(ada_b + l * 6144 + off);
#pragma unroll
    for (int kc = 0; kc < 8; ++kc) p[kc + 1] = *(const f32x4*)(MODP + (size_t)((l * 8 + kc) * 4 + b) * 6144 + off);
    f32x4 v = p[0];
#pragma unroll
    for (int kc = 0; kc < 8; ++kc) v += p[kc + 1];
    *(f32x4*)((which ? dstB : dstA) + c4) = v;
}
__device__ __forceinline__ void mod_finalize(const Params& P, int l, int bx, int tid) {
    const int idx = bx * NTHR + tid; if (idx >= 6144) return;
    const int b = idx / 1536, c4 = (idx % 1536) * 4; const float* MODP = (const float*)(P.ws + WS_MODP);
    f32x4 p[9]; p[0] = *(const f32x4*)(P.in[3] + l * 6144 + c4);
#pragma unroll
    for (int kc = 0; kc < 8; ++kc) p[kc + 1] = *(const f32x4*)(MODP + (size_t)((l * 8 + kc) * 4 + b) * 6144 + c4);
    f32x4 v = p[0];
#pragma unroll
    for (int kc = 0; kc < 8; ++kc) v += p[kc + 1];
    *(f32x4*)((float*)(P.ws + WS_MODF) + (size_t)(l * 4 + b) * 6144 + c4) = v;
}
template <bool ROUTER>
__device__ __forceinline__ void rowpass(const Params& P, unsigned char* lds, const float* X, const float* gain, int l, int sh_off, int sc_off, int bx, int G, int tid, int wave, int lane) {
    const float* ada_b = P.in[3]; const float* MODP = (const float*)(P.ws + WS_MODP);
    bf16* XN = (bf16*)(P.ws + WS_XN);
    float* mA = (float*)lds; float* mB = mA + 1024;
    for (int wi0 = bx * NWAVES; wi0 < M / 8; wi0 += G * NWAVES) {
        const int wi = wi0 + wave, row0 = wi * 8, b = (wi0 * 8) >> 12;
        __syncthreads();
        stage_mod2(ada_b, MODP, l, b, sc_off, sh_off, mA, mB, tid);
        __syncthreads();
        f32x4 sg[4], sh[4]; const unsigned lob = 16u * (unsigned)lane;
#pragma unroll
        for (int j = 0; j < 4; ++j) { const f32x4 g = ldu4(gain + 256 * j, lob); sg[j] = (*(const f32x4*)(mA + 4 * lane + 256 * j) + 1.0f) * g; sh[j] = *(const f32x4*)(mB + 4 * lane + 256 * j); }
        unsigned hcnt = 0u;
        f32x4 nx[2][4];
#pragma unroll
        for (int r = 0; r < 2; ++r)
#pragma unroll
            for (int j = 0; j < 4; ++j) nx[r][j] = ldu4(X + (size_t)(row0 + r) * DM + 256 * j, lob);
#pragma unroll 1
        for (int grp = 0; grp < 4; ++grp) {
            f32x4 hrow[2][4];
#pragma unroll
            for (int r = 0; r < 2; ++r)
#pragma unroll
                for (int j = 0; j < 4; ++j) hrow[r][j] = nx[r][j];
            if (grp < 3) {
#pragma unroll
                for (int r = 0; r < 2; ++r)
#pragma unroll
                    for (int j = 0; j < 4; ++j) nx[r][j] = ldu4(X + (size_t)(row0 + 2 * grp + 2 + r) * DM + 256 * j, lob); }
#pragma unroll
            for (int r = 0; r < 2; ++r) {
                const int row = row0 + 2 * grp + r;
                float ss = 0.f;
#pragma unroll
                for (int j = 0; j < 4; ++j) { const f32x4 v = hrow[r][j]; ss += (v[0] * v[0] + v[1] * v[1]) + (v[2] * v[2] + v[3] * v[3]); }
                const float rs = rsqrtf(wave_sum(ss) * (1.0f / DM) + EPSN);
#pragma unroll
                for (int j = 0; j < 4; ++j) { const f32x4 v = hrow[r][j] * rs * sg[j] + sh[j]; u32x2 w; w.x = pk2(v[0], v[1]); w.y = pk2(v[2], v[3]);
                    *(u32x2*)((char*)(XN + (size_t)row * DM + 256 * j) + (lob >> 1)) = w; hrow[r][j] = v; }
            }
            if constexpr (ROUTER) {
                const float* rwt = (const float*)(P.ws + WS_RWT);
                float pv[16];
#pragma unroll
                for (int e = 0; e < 8; ++e) { f32x4 w[4];
#pragma unroll
                    for (int j = 0; j < 4; ++j) w[j] = ldu4(rwt + e * 1024 + 256 * j, lob);
#pragma unroll
                    for (int r = 0; r < 2; ++r) { float a = 0.f;
#pragma unroll
                        for (int j = 0; j < 4; ++j) a += (hrow[r][j][0] * w[j][0] + hrow[r][j][1] * w[j][1]) + (hrow[r][j][2] * w[j][2] + hrow[r][j][3] * w[j][3]);
                        pv[r * 8 + e] = a; } }
                bfly_reduce<8>(pv, lane);
                float lg = pv[0]; lg += __shfl_xor(lg, 16); lg += __shfl_xor(lg, 32);
                const int e = lane & 7;
                float v1 = lg; int i1 = e;
#pragma unroll
                for (int of = 1; of < 8; of <<= 1) { const float ov = __shfl_xor(v1, of); const int oi = __shfl_xor(i1, of); if (ov > v1 || (ov == v1 && oi < i1)) { v1 = ov; i1 = oi; } }
                float v2 = (e == i1) ? -3.0e38f : lg; int i2 = e;
#pragma unroll
                for (int of = 1; of < 8; of <<= 1) { const float ov = __shfl_xor(v2, of); const int oi = __shfl_xor(i2, of); if (ov > v2 || (ov == v2 && oi < i2)) { v2 = ov; i2 = oi; } }
                if (lane < 16 && e == 0) { const int row = row0 + 2 * grp + (lane >> 3);
                    const float w1 = 1.0f / (1.0f + __expf(v2 - v1));
                    int* TI = (int*)(P.ws + WS_TOPI); float* TW = (float*)(P.ws + WS_TOPW);
                    TI[row * 2] = i1; TI[row * 2 + 1] = i2; TW[row * 2] = w1; TW[row * 2 + 1] = 1.0f - w1; }
                unsigned c = (i1 == e ? 1u : 0u) + (i2 == e ? 1u : 0u);
                c += __shfl_xor(c, 8);
                hcnt += c;
            }
        }
        if constexpr (ROUTER) { if (lane < 8) ((unsigned*)(P.ws + WS_WCNT))[(size_t)wi * 8 + lane] = hcnt; }
    }
    __syncthreads();
}

__device__ __forceinline__ void moe_scatter(const Params& P, unsigned char* lds, int bx, int G, int tid, int wave, int lane) {
    unsigned* ctl = (unsigned*)(P.ws + WS_CTL); const unsigned* WC = (const unsigned*)(P.ws + WS_WCNT);
    int* sh = (int*)lds;
    const int* TI = (const int*)(P.ws + WS_TOPI); int* DE = (int*)(P.ws + WS_DEST);
    const bf16* XN = (const bf16*)(P.ws + WS_XN); bf16* XG = (bf16*)(P.ws + WS_XG);
    constexpr int NWI = M / 8;
    if (tid < 16) sh[tid] = 0;
    __syncthreads();
    {
        unsigned a = 0; for (int i = tid; i < NWI * 8; i += NTHR) a += WC[i];
        atomicAdd(&sh[tid & 7], (int)a);
    }
    __syncthreads();
    int pstart[8]; { int acc = 0;
#pragma unroll
        for (int e = 0; e < 8; ++e) { pstart[e] = acc; acc += ((sh[e] + 255) >> 8) << 8; } }
    if (bx == 0 && tid < 8) ctl[CW_CNT + tid] = (unsigned)sh[tid];
    for (int wi0 = bx * NWAVES; wi0 < NWI; wi0 += G * NWAVES) {
        __syncthreads();
        if (tid < 8) sh[8 + tid] = 0;
        __syncthreads();
        { unsigned a = 0; for (int i = tid; i < wi0 * 8; i += NTHR) a += WC[i]; atomicAdd(&sh[8 + (tid & 7)], (int)a); }
        __syncthreads();
        const int wi = wi0 + wave;
        int base[8];
#pragma unroll
        for (int e = 0; e < 8; ++e) { int a = pstart[e] + sh[8 + e]; for (int w = wi0; w < wi; ++w) a += (int)WC[w * 8 + e]; base[e] = a; }
        for (int r = 0; r < 8; ++r) { const int row = wi * 8 + r;
            const u32x4 a = *(const u32x4*)(XN + (size_t)row * DM + 8 * lane), b2 = *(const u32x4*)(XN + (size_t)row * DM + 512 + 8 * lane);
#pragma unroll
            for (int k = 0; k < 2; ++k) { const int e = TI[row * 2 + k];
                int dest = 0;
#pragma unroll
                for (int q = 0; q < 8; ++q) { if (e == q) { dest = base[q]; base[q] += 1; } }
                if (lane == 0) DE[row * 2 + k] = dest;
                *(u32x4*)(XG + (size_t)dest * DM + 8 * lane) = a; *(u32x4*)(XG + (size_t)dest * DM + 512 + 8 * lane) = b2; } }
    }
    __syncthreads();
}

__device__ __forceinline__ void moe_combine_final(const Params& P, unsigned char* lds, int bx, int G, int tid, int wave, int lane) {
    const float* ada_b = P.in[3]; const float* MODP = (const float*)(P.ws + WS_MODP); const float* fg = P.in[22];
    const int* DE = (const int*)(P.ws + WS_DEST); const float* TW = (const float*)(P.ws + WS_TOPW); const float* YG = (const float*)(P.ws + WS_YG);
    float* mA = (float*)lds; float* mB = mA + 1024;
    for (int wi0 = bx * NWAVES; wi0 < M / 8; wi0 += G * NWAVES) {
        const int wi = wi0 + wave, row0 = wi * 8, b = (wi0 * 8) >> 12;
        __syncthreads();
        stage_mod2(ada_b, MODP, 1, b, 5120, 5120, mA, mB, tid);
        __syncthreads();
        f32x4 g2[4], g[4];
#pragma unroll
        for (int j = 0; j < 4; ++j) { const int col = 4 * lane + 256 * j; g2[j] = *(const f32x4*)(mA + col); g[j] = *(const f32x4*)(fg + col); }
        for (int r = 0; r < 8; ++r) { const int row = row0 + r; const int d0 = DE[row * 2], d1 = DE[row * 2 + 1]; const float w0 = TW[row * 2], w1 = TW[row * 2 + 1];
            float* xr = P.out + (size_t)row * DM + 4 * lane; f32x4 v[4]; float ss = 0.f;
#pragma unroll
            for (int j = 0; j < 4; ++j) { const f32x4 y0 = *(const f32x4*)(YG + (size_t)d0 * DM + 4 * lane + 256 * j), y1 = *(const f32x4*)(YG + (size_t)d1 * DM + 4 * lane + 256 * j);
                v[j] = *(const f32x4*)(xr + 256 * j) + g2[j] * (w0 * y0 + w1 * y1); ss += (v[j][0] * v[j][0] + v[j][1] * v[j][1]) + (v[j][2] * v[j][2] + v[j][3] * v[j][3]); }
            const float rs = rsqrtf(wave_sum(ss) * (1.0f / DM) + EPSN);
#pragma unroll
            for (int j = 0; j < 4; ++j) *(f32x4*)(xr + 256 * j) = v[j] * rs * g[j]; }
    }
    __syncthreads();
}

#define LAS __attribute__((address_space(3)))
#define XB_TMO      128
#define XB_XCNT(j)  (256  + 64 * (j))
#define XB_XSUB(j)  (1280 + 64 * (j))
#define XB_XGEN(j)  (2304 + 64 * (j))
#define XB_TOP      3328
#define XB_TOPGEN   3392
#define XCD_BAR_WORDS 3456
#define XB_SPIN_CAP (1u << 18)

__device__ __forceinline__ unsigned xb_ld(unsigned* p)              { return __hip_atomic_load(p, __ATOMIC_RELAXED, __HIP_MEMORY_SCOPE_AGENT); }
__device__ __forceinline__ unsigned xb_add(unsigned* p, unsigned v) { return __hip_atomic_fetch_add(p, v, __ATOMIC_RELAXED, __HIP_MEMORY_SCOPE_AGENT); }
__device__ __forceinline__ unsigned xb_xcc_id() { return (unsigned)__builtin_amdgcn_s_getreg((3 << 11) | 20) & 0xFu; }
#define XB_SPIN(cond, bar) do { unsigned _sp = 0; while (cond) { __builtin_amdgcn_s_sleep(1); \
    if ((++_sp & 255u) == 0u) { if (xb_ld(&(bar)[XB_TMO])) break; if (_sp > XB_SPIN_CAP) { atomicAdd(&(bar)[XB_TMO], 1u); break; } } } } while (0)

struct XcdBarrier {
    unsigned* bar; unsigned x;
    volatile LAS unsigned* st;
};

__device__ __forceinline__ XcdBarrier xcd_barrier_post(unsigned* bar, volatile LAS unsigned* st) {
    XcdBarrier b; b.bar = bar; b.x = xb_xcc_id(); b.st = st;
    if (threadIdx.x == 0) (void)xb_add(&bar[XB_XCNT(b.x)], 1u);
    return b;
}
__device__ __forceinline__ void xcd_barrier_complete(unsigned* bar, unsigned x, unsigned& nloc, unsigned& nx) {
    const unsigned G = gridDim.x * gridDim.y * gridDim.z;
    unsigned sum, cnt, mine, sp = 0u;
    for (;;) {
        sum = 0u; cnt = 0u; mine = 0u;
#pragma unroll
        for (unsigned j = 0; j < 16; ++j) { const unsigned c = xb_ld(&bar[XB_XCNT(j)]); sum += c; cnt += (c > 0u) ? 1u : 0u; mine = (j == x) ? c : mine; }
        if (sum == G) break;
        __builtin_amdgcn_s_sleep(1);
        if ((++sp & 255u) == 0u) { if (xb_ld(&bar[XB_TMO])) break; if (sp > XB_SPIN_CAP) { atomicAdd(&bar[XB_TMO], 1u); break; } }
    }
    nloc = mine > 0u ? mine : 1u; nx = cnt > 0u ? cnt : 1u;
}

__device__ __forceinline__ void xcd_barrier(const XcdBarrier& b) {
    asm volatile("s_waitcnt vmcnt(0)" ::: "memory");
    __syncthreads();
    if (threadIdx.x == 0) {
        unsigned* bar = b.bar;
        __builtin_amdgcn_s_waitcnt(0);
        unsigned nloc = b.st[0], nx = b.st[1];
        if (nloc == 0u) { xcd_barrier_complete(bar, b.x, nloc, nx); b.st[0] = nloc; b.st[1] = nx; }
        const unsigned old = xb_add(&bar[XB_XSUB(b.x)], 1u);
        const unsigned gen = old / nloc;
        if (old + 1u == (gen + 1u) * nloc) {
            __builtin_amdgcn_fence(__ATOMIC_RELEASE, "agent");
            asm volatile("s_waitcnt vmcnt(0)" ::: "memory");
            const unsigned og = xb_add(&bar[XB_TOP], 1u);
            const unsigned tg = og / nx;
            if (og + 1u == (tg + 1u) * nx) xb_add(&bar[XB_TOPGEN], 1u);
            else XB_SPIN(xb_ld(&bar[XB_TOPGEN]) == tg, bar);
            __builtin_amdgcn_fence(__ATOMIC_ACQUIRE, "agent");
            xb_add(&bar[XB_XGEN(b.x)], 1u);
            asm volatile("s_waitcnt vmcnt(0)" ::: "memory");
        } else {
            XB_SPIN(xb_ld(&bar[XB_XGEN(b.x)]) == gen, bar);
            __builtin_amdgcn_fence(__ATOMIC_ACQUIRE, "agent");
            asm volatile("s_waitcnt vmcnt(0)" ::: "memory");
        }
    }
    __syncthreads();
}

__device__ __forceinline__ f32x16 mfma32(bf16x8 a, bf16x8 b, f32x16 c) { return __builtin_amdgcn_mfma_f32_32x32x16_bf16(a, b, c, 0, 0, 0); }
__device__ __forceinline__ f32x4 mfma16(bf16x8 a, bf16x8 b, f32x4 c) { return __builtin_amdgcn_mfma_f32_16x16x32_bf16(a, b, c, 0, 0, 0); }
__device__ __forceinline__ int rowmap(int i, int hh) { return (i & 3) + 8 * (i >> 2) + 4 * hh; }
__device__ __forceinline__ bf16x8 ld8(const bf16* p) { return *(const bf16x8*)p; }
__device__ __forceinline__ bf16x8 ld44(const bf16* p) { const u32x2 lo = *(const u32x2*)p, hi = *(const u32x2*)(p + 8); u32x4 v; v.x = lo.x; v.y = lo.y; v.z = hi.x; v.w = hi.y; return __builtin_bit_cast(bf16x8, v); }
typedef short v4i16_t __attribute__((ext_vector_type(4)));
__device__ __forceinline__ bf16x8 ldtr8(const bf16* vb) {
    const v4i16_t lo = __builtin_amdgcn_ds_read_tr16_b64_v4i16((__attribute__((address_space(3))) v4i16_t*)vb);
    const v4i16_t hi = __builtin_amdgcn_ds_read_tr16_b64_v4i16((__attribute__((address_space(3))) v4i16_t*)(vb + 8 * 32));
    return (bf16x8){lo[0], lo[1], lo[2], lo[3], hi[0], hi[1], hi[2], hi[3]};
}
__device__ __forceinline__ bf16x8 pack8(const f32x16& p, int s) {
    u32x4 v; v.x = pk2(p[8 * s], p[8 * s + 1]); v.y = pk2(p[8 * s + 2], p[8 * s + 3]); v.z = pk2(p[8 * s + 4], p[8 * s + 5]); v.w = pk2(p[8 * s + 6], p[8 * s + 7]);
    return __builtin_bit_cast(bf16x8, v);
}
__device__ __forceinline__ float wave_scan_add(float v, int lane) {
#pragma unroll
    for (int o = 1; o < 64; o <<= 1) { const float t = __shfl_up(v, o); if (lane >= o) v += t; }
    return v;
}
__device__ __forceinline__ float wave_scan_max(float v, int lane) {
#pragma unroll
    for (int o = 1; o < 64; o <<= 1) { const float t = __shfl_up(v, o); if (lane >= o) v = fmaxf(v, t); }
    return v;
}

__device__ __forceinline__ void compress_unit(const Params& P, unsigned char* lds, int l, int u, int tid) {
    asm volatile("" : "+v"(tid));
    const int j = u >> 7, b = (u >> 5) & 3, g = (u >> 4) & 1, nb = u & 15, lj = l * 2 + j;
    const int wave = tid >> 6, lane = tid & 63;
    bf16* T = (bf16*)lds;
    float* Hs = (float*)(lds + 272 * 144);
    const bf16* PROJ = (const bf16*)(P.ws + WS_PROJ);
    for (int idx = tid; idx < 272 * 8; idx += NTHR) { const int row = idx >> 3, ch = idx & 7, tok = 256 * nb + row;
        u32x4 v = {0u, 0u, 0u, 0u};
        if (tok < SEQ) v = *(const u32x4*)(PROJ + (size_t)(b * SEQ + tok) * PLD + C_KV + j * 128 + g * 64 + ch * 8);
        *(u32x4*)(T + ((row & 15) * 17 + (row >> 4)) * 72 + ch * 8) = v; }
    __syncthreads();
    {
        f32x4 acc = {0.f, 0.f, 0.f, 0.f};
        const bf16* wrow = (const bf16*)(P.ws + WS_W1T) + ((size_t)lj * 128 + 16 * wave + (lane & 15)) * 2048 + 8 * (lane >> 4);
        const bf16* arow = T + (lane & 15) * 72 + 8 * (lane >> 4);
#pragma unroll 16
        for (int st = 0; st < 64; ++st) { const int p_ = st >> 1; const bf16x8 a = ld8(arow + ((p_ & 15) * 17 + (p_ >> 4)) * 72 + 32 * (st & 1)); const bf16x8 bb = ld8(wrow + 32 * st); acc = mfma16(a, bb, acc); }
        const int hid = 16 * wave + (lane & 15);
        float c1 = 0.f; const float* c1p = (const float*)(P.ws + WS_C1P) + (size_t)lj * 16 * 128 + hid;
#pragma unroll
        for (int kc = 0; kc < 16; ++kc) c1 += c1p[kc * 128];
#pragma unroll
        for (int r = 0; r < 4; ++r) Hs[(4 * (lane >> 4) + r) * 128 + hid] = siluf_(acc[r] + c1);
    }
    __syncthreads();
    {
        const int n = tid >> 5, dd = (tid & 31) * 2; const float* w2 = P.in[10] + (size_t)lj * 128 * 64 + dd; const float* hs = Hs + n * 128;
        float o0 = 0.f, o1 = 0.f;
#pragma unroll 8
        for (int h = 0; h < 128; ++h) { const float x = hs[h]; o0 += x * w2[h * 64]; o1 += x * w2[h * 64 + 1]; }
        const int ng = 16 * nb + n; if (ng == 255) { o0 = 0.f; o1 = 0.f; }
        bf16* KC = (bf16*)(P.ws + WS_KC) + ((size_t)((j * 4 + b) * 2 + g) * 256 + ng) * 64 + dd;
        *(unsigned*)KC = pk2(o0, o1);
    }
    __syncthreads();
}

__device__ __forceinline__ void conv16(const Params& P, int l, int b, int t, int col0, int cch0, float scale, float (&out)[16]) {
    const bf16* PROJ = (const bf16*)(P.ws + WS_PROJ);
    const float* cw = P.in[11] + (size_t)l * 4 * 1024 + cch0; const float* cb = P.in[12] + (size_t)l * 1024 + cch0;
#pragma unroll
    for (int q = 0; q < 4; ++q) { const f32x4 bb = *(const f32x4*)(cb + 4 * q); out[4 * q] = bb[0]; out[4 * q + 1] = bb[1]; out[4 * q + 2] = bb[2]; out[4 * q + 3] = bb[3]; }
#pragma unroll
    for (int i = 0; i < 4; ++i) { const int tt = t - 3 + i;
        if (tt >= 0) { const bf16* xr = PROJ + (size_t)(b * SEQ + tt) * PLD + col0; const u32x4 x0 = *(const u32x4*)xr, x1 = *(const u32x4*)(xr + 8);
            const unsigned xs[8] = {x0.x, x0.y, x0.z, x0.w, x1.x, x1.y, x1.z, x1.w};
#pragma unroll
            for (int q = 0; q < 4; ++q) { const f32x4 w = *(const f32x4*)(cw + i * 1024 + 4 * q);
                out[4 * q] += w[0] * bf2f(xs[2 * q] & 0xffffu); out[4 * q + 1] += w[1] * bf2f(xs[2 * q] >> 16); out[4 * q + 2] += w[2] * bf2f(xs[2 * q + 1] & 0xffffu); out[4 * q + 3] += w[3] * bf2f(xs[2 * q + 1] >> 16); } } }
#pragma unroll
    for (int q = 0; q < 16; ++q) out[q] = siluf_(out[q]) * scale;
}

__device__ __forceinline__ void mlstm_local_unit(const Params& P, unsigned char* lds, int l, int u, int tid) {
    asm volatile("" : "+v"(tid));
    const int bh = u >> 6, c = u & 63, b = bh >> 2, h = bh & 3, wave = tid >> 6, lane = tid & 63, r32 = lane & 31, hh = lane >> 5;
    bf16* Kt = (bf16*)lds;
    bf16* Vt = (bf16*)(lds + 18432);
    float* wS = (float*)(lds + 36864);
    const float* GATES = (const float*)(P.ws + WS_GATES); const bf16* PROJ = (const bf16*)(P.ws + WS_PROJ);
    const int tok0 = 64 * c;
    if (wave == 0) {
        const float* gr = GATES + (size_t)(b * SEQ + tok0 + lane) * 32;
        const float lf = logsigmoidf_(gr[28 + h]), ig = gr[24 + h];
        const float a = wave_scan_add(lf, lane), aL = __shfl(a, 63);
        const float lw = aL - a + ig, ml = wave_max(lw);
        wS[lane] = __expf(lw - ml);
        if (lane == 0) { float* SC = (float*)(P.ws + WS_SC); SC[u * 2] = aL; SC[u * 2 + 1] = ml; }
    }
    __syncthreads();
    {
        const int s = tid >> 3, ch = tid & 7, d0 = 16 * ch; float kv[16];
        conv16(P, l, b, tok0 + s, C_QKM + 512 + h * 128 + d0, 512 + h * 128 + d0, 0.08838834764831845f, kv);
#pragma unroll
        for (int q = 0; q < 16; ++q) Kt[(d0 + q) * 72 + s] = (bf16)f2bf(kv[q]);
        {
            bf16* kq = (bf16*)(P.ws + WS_XN) + (size_t)(b * SEQ + tok0 + s) * DM + h * 128 + d0; u32x4 w0, w1;
            w0.x = pk2(kv[0], kv[1]); w0.y = pk2(kv[2], kv[3]); w0.z = pk2(kv[4], kv[5]); w0.w = pk2(kv[6], kv[7]); w1.x = pk2(kv[8], kv[9]); w1.y = pk2(kv[10], kv[11]); w1.z = pk2(kv[12], kv[13]); w1.w = pk2(kv[14], kv[15]);
            *(u32x4*)(kq + 512) = w0; *(u32x4*)(kq + 520) = w1;
            float qv[16]; conv16(P, l, b, tok0 + s, C_QKM + h * 128 + d0, h * 128 + d0, 1.0f, qv);
            w0.x = pk2(qv[0], qv[1]); w0.y = pk2(qv[2], qv[3]); w0.z = pk2(qv[4], qv[5]); w0.w = pk2(qv[6], qv[7]); w1.x = pk2(qv[8], qv[9]); w1.y = pk2(qv[10], qv[11]); w1.z = pk2(qv[12], qv[13]); w1.w = pk2(qv[14], qv[15]);
            *(u32x4*)(kq) = w0; *(u32x4*)(kq + 8) = w1; }
        const bf16* vr = PROJ + (size_t)(b * SEQ + tok0 + s) * PLD + C_VM + h * 128 + d0; const u32x4 x0 = *(const u32x4*)vr, x1 = *(const u32x4*)(vr + 8);
        const unsigned xs[8] = {x0.x, x0.y, x0.z, x0.w, x1.x, x1.y, x1.z, x1.w}; const float w = wS[s];
#pragma unroll
        for (int q = 0; q < 8; ++q) { Vt[(d0 + 2 * q) * 72 + s] = (bf16)f2bf(bf2f(xs[q] & 0xffffu) * w); Vt[(d0 + 2 * q + 1) * 72 + s] = (bf16)f2bf(bf2f(xs[q] >> 16) * w); }
    }
    __syncthreads();
    {
        const int et = wave >> 1, dt0 = 2 * (wave & 1);
        f32x16 acc0 = {}, acc1 = {};
#pragma unroll
        for (int st = 0; st < 4; ++st) { const bf16x8 a = ld8(Vt + (32 * et + r32) * 72 + 16 * st + 8 * hh);
            acc0 = mfma32(a, ld8(Kt + (32 * dt0 + r32) * 72 + 16 * st + 8 * hh), acc0);
            acc1 = mfma32(a, ld8(Kt + (32 * (dt0 + 1) + r32) * 72 + 16 * st + 8 * hh), acc1); }
        float* LC = (float*)(P.ws + WS_LC) + (size_t)u * 16384;
#pragma unroll
        for (int i = 0; i < 16; ++i) { const int e = 32 * et + rowmap(i, hh); LC[e * 128 + 32 * dt0 + r32] = acc0[i]; LC[e * 128 + 32 * (dt0 + 1) + r32] = acc1[i]; }
    }
    if (tid < 128) { float nl = 0.f;
#pragma unroll 8
        for (int s = 0; s < 64; ++s) nl += wS[s] * bf2f(Kt[tid * 72 + s]);
        ((float*)(P.ws + WS_NL))[u * 128 + tid] = nl; }
    __syncthreads();
}

__device__ __forceinline__ void mlstm_scan(const Params& P, int gtid, int gthreads) {
    const float* __restrict__ LC = (const float*)(P.ws + WS_LC); const float* __restrict__ NL = (const float*)(P.ws + WS_NL); const float* __restrict__ SC = (const float*)(P.ws + WS_SC);
    bf16* __restrict__ CP = (bf16*)(P.ws + WS_CP); float* __restrict__ NP = (float*)(P.ws + WS_NP); float* __restrict__ MP = (float*)(P.ws + WS_MP);
    for (int gt = gtid; gt < 16 * 16512; gt += gthreads) {
        const int bh = gt / 16512, el = gt % 16512; const bool isn = el >= 16384;
        float C = 0.f, m = 0.f;
        for (int c0 = 0; c0 < 64; c0 += 16) {
            float Lv[16], aL[16], ml[16];
#pragma unroll
            for (int k = 0; k < 16; ++k) { const int u = bh * 64 + c0 + k; Lv[k] = isn ? NL[u * 128 + (el - 16384)] : LC[(size_t)u * 16384 + el]; aL[k] = SC[u * 2]; ml[k] = SC[u * 2 + 1]; }
#pragma unroll
            for (int k = 0; k < 16; ++k) { const int u = bh * 64 + c0 + k;
                if (isn) NP[u * 128 + (el - 16384)] = C; else CP[(size_t)u * 16384 + el] = (bf16)f2bf(C);
                if (el == 0) MP[u] = m;
                const float mn = fmaxf(aL[k] + m, ml[k]);
                C = __expf(aL[k] + m - mn) * C + __expf(ml[k] - mn) * Lv[k]; m = mn; }
        }
    }
}

__device__ __forceinline__ void mlstm_out_unit(const Params& P, unsigned char* lds, int l, int u, int tid) {
    asm volatile("" : "+v"(tid));
    const int bh = u >> 6, c = u & 63, b = bh >> 2, h = bh & 3, wave = tid >> 6, lane = tid & 63, r32 = lane & 31, hh = lane >> 5;
    bf16* Qs = (bf16*)lds;
    bf16* Ks = (bf16*)(lds + 17408);
    bf16* Vt = (bf16*)(lds + 34816);
    float* aS = (float*)(lds + 53248);
    float* bS = aS + 64;
    float* GS = aS + 128;
    float* nq = aS + 192;
    float* ssq = aS + 256;
    const float* GATES = (const float*)(P.ws + WS_GATES); const bf16* PROJ = (const bf16*)(P.ws + WS_PROJ);
    const int tok0 = 64 * c; const float mprev = ((const float*)(P.ws + WS_MP))[u];
    if (wave == 0) {
        const float* gr = GATES + (size_t)(b * SEQ + tok0 + lane) * 32;
        const float lf = logsigmoidf_(gr[28 + h]), ig = gr[24 + h];
        const float a = wave_scan_add(lf, lane), bb = ig - a, pm = wave_scan_max(bb, lane);
        aS[lane] = a; bS[lane] = bb; GS[lane] = fmaxf(mprev, pm);
    }
    {
        const int s = tid >> 3, ch = tid & 7, d0 = 16 * ch; float qv[16], kv[16];
        conv16(P, l, b, tok0 + s, C_QKM + h * 128 + d0, h * 128 + d0, 1.0f, qv);
        conv16(P, l, b, tok0 + s, C_QKM + 512 + h * 128 + d0, 512 + h * 128 + d0, 0.08838834764831845f, kv);
        u32x4 w0, w1;
        w0.x = pk2(qv[0], qv[1]); w0.y = pk2(qv[2], qv[3]); w0.z = pk2(qv[4], qv[5]); w0.w = pk2(qv[6], qv[7]); w1.x = pk2(qv[8], qv[9]); w1.y = pk2(qv[10], qv[11]); w1.z = pk2(qv[12], qv[13]); w1.w = pk2(qv[14], qv[15]);
        *(u32x4*)(Qs + s * 136 + d0) = w0; *(u32x4*)(Qs + s * 136 + d0 + 8) = w1;
        w0.x = pk2(kv[0], kv[1]); w0.y = pk2(kv[2], kv[3]); w0.z = pk2(kv[4], kv[5]); w0.w = pk2(kv[6], kv[7]); w1.x = pk2(kv[8], kv[9]); w1.y = pk2(kv[10], kv[11]); w1.z = pk2(kv[12], kv[13]); w1.w = pk2(kv[14], kv[15]);
        *(u32x4*)(Ks + s * 136 + d0) = w0; *(u32x4*)(Ks + s * 136 + d0 + 8) = w1;
        const bf16* vr = PROJ + (size_t)(b * SEQ + tok0 + s) * PLD + C_VM + h * 128 + d0; const u32x4 x0 = *(const u32x4*)vr, x1 = *(const u32x4*)(vr + 8);
        const unsigned xs[8] = {x0.x, x0.y, x0.z, x0.w, x1.x, x1.y, x1.z, x1.w};
#pragma unroll
        for (int q = 0; q < 8; ++q) { Vt[(d0 + 2 * q) * 72 + s] = (bf16)(xs[q] & 0xffffu); Vt[(d0 + 2 * q + 1) * 72 + s] = (bf16)(xs[q] >> 16); }
    }
    __syncthreads();
    {
        const int jq = tid >> 3, part = tid & 7; const float* np = (const float*)(P.ws + WS_NP) + (size_t)u * 128 + part * 16; float a = 0.f;
#pragma unroll
        for (int d = 0; d < 16; ++d) a += np[d] * bf2f(Qs[jq * 136 + part * 16 + d]);
        a += __shfl_xor(a, 1); a += __shfl_xor(a, 2); a += __shfl_xor(a, 4);
        if (part == 0) nq[jq] = a;
    }
    __syncthreads();
    const int et = wave >> 1, jt = wave & 1, jl = 32 * jt + r32;
    bf16x8 qf[8];
#pragma unroll
    for (int st = 0; st < 8; ++st) qf[st] = ld8(Qs + jl * 136 + 16 * st + 8 * hh);
    const float Gj = GS[jl], inter = __expf(mprev - Gj);
    f32x16 acc = {};
    {
        const bf16* cp = (const bf16*)(P.ws + WS_CP) + (size_t)u * 16384 + (32 * et + r32) * 128 + 8 * hh;
#pragma unroll
        for (int st = 0; st < 8; ++st) acc = mfma32(ld8(cp + 16 * st), qf[st], acc);
#pragma unroll
        for (int i = 0; i < 16; ++i) acc[i] *= inter;
    }
    float colsum = 0.f;
#pragma unroll
    for (int kt = 0; kt < 2; ++kt) {
        if (kt <= jt) {
            f32x16 sd = {};
#pragma unroll
            for (int st = 0; st < 8; ++st) sd = mfma32(ld8(Ks + (32 * kt + r32) * 136 + 16 * st + 8 * hh), qf[st], sd);
#pragma unroll
            for (int i = 0; i < 16; ++i) { const int s = 32 * kt + rowmap(i, hh); const float dv = (s <= jl) ? __expf(bS[s] - Gj) : 0.f; sd[i] *= dv; colsum += sd[i]; }
#pragma unroll
            for (int s2 = 0; s2 < 2; ++s2) acc = mfma32(ld44(Vt + (32 * et + r32) * 72 + 32 * kt + 16 * s2 + 4 * hh), pack8(sd, s2), acc);
        }
    }
    colsum += __shfl_xor(colsum, 32);
    const float den = inter * nq[jl] + colsum, dn = fmaxf(fabsf(den), __expf(-(aS[jl] + Gj))), rdn = 1.0f / dn;
    const int trow = b * SEQ + tok0 + jl;
    float part = 0.f;
#pragma unroll
    for (int q = 0; q < 4; ++q) { const int e0 = 32 * et + 8 * q + 4 * hh;
        const u32x2 ov = *(const u32x2*)(PROJ + (size_t)trow * PLD + C_OM + h * 128 + e0);
        const float o0 = bf2f(ov.x & 0xffffu), o1 = bf2f(ov.x >> 16), o2 = bf2f(ov.y & 0xffffu), o3 = bf2f(ov.y >> 16);
        acc[4 * q] *= rdn * sigmoidf_(o0); acc[4 * q + 1] *= rdn * sigmoidf_(o1); acc[4 * q + 2] *= rdn * sigmoidf_(o2); acc[4 * q + 3] *= rdn * sigmoidf_(o3);
        part += acc[4 * q] * acc[4 * q] + acc[4 * q + 1] * acc[4 * q + 1] + acc[4 * q + 2] * acc[4 * q + 2] + acc[4 * q + 3] * acc[4 * q + 3]; }
    part += __shfl_xor(part, 32);
    if (hh == 0) ssq[et * 64 + jl] = part;
    __syncthreads();
    const float tot = ssq[jl] + ssq[64 + jl] + ssq[128 + jl] + ssq[192 + jl], rstd = rsqrtf(tot * (1.0f / 128.0f) + EPSN);
    const float* ng = P.in[13] + (size_t)l * 512 + h * 128; bf16* Y = (bf16*)(P.ws + WS_Y) + (size_t)trow * DM + 512 + h * 128;
#pragma unroll
    for (int q = 0; q < 4; ++q) { const int e0 = 32 * et + 8 * q + 4 * hh; const f32x4 gg = *(const f32x4*)(ng + e0);
        u32x2 w; w.x = pk2(acc[4 * q] * rstd * gg[0], acc[4 * q + 1] * rstd * gg[1]); w.y = pk2(acc[4 * q + 2] * rstd * gg[2], acc[4 * q + 3] * rstd * gg[3]);
        *(u32x2*)(Y + e0) = w; }
    __syncthreads();
}

__device__ __forceinline__ int tb_off(int row, int col) { return (col >> 5) * 2048 + row * 32 + (col & 31); }
__device__ __forceinline__ bf16x8 ldtr_nat(const bf16* tile, int cb, int s0, int lane) {
    const bf16* p = tile + cb * 2048 + (s0 + 8 * (lane >> 5) + ((lane & 15) >> 2)) * 32 + 16 * ((lane >> 4) & 1) + 4 * (lane & 3);
    const v4i16_t lo = __builtin_amdgcn_ds_read_tr16_b64_v4i16((__attribute__((address_space(3))) v4i16_t*)p);
    const v4i16_t hi = __builtin_amdgcn_ds_read_tr16_b64_v4i16((__attribute__((address_space(3))) v4i16_t*)(p + 4 * 32));
    return (bf16x8){lo[0], lo[1], lo[2], lo[3], hi[0], hi[1], hi[2], hi[3]};
}
__device__ __forceinline__ void mlstm_local_wave(const Params& P, unsigned char* ldsw, float* wS, int l, int u, int lane) {
    const int bh = u >> 6, c = u & 63, b = bh >> 2, h = bh & 3, r32 = lane & 31, hh = lane >> 5, tok0 = 64 * c;
    bf16* Kt = (bf16*)ldsw; bf16* Vb = (bf16*)(ldsw + 16384);
    const float* GATES = (const float*)(P.ws + WS_GATES); const bf16* PROJ = (const bf16*)(P.ws + WS_PROJ); bf16* KQC = (bf16*)(P.ws + WS_XN);
    {
        const float* gr = GATES + (size_t)(b * SEQ + tok0 + lane) * 32;
        const float lf = logsigmoidf_(gr[28 + h]), ig = gr[24 + h];
        const float a = wave_scan_add(lf, lane), aL = __shfl(a, 63);
        const float lw = aL - a + ig, ml = wave_max(lw);
        wS[lane] = __expf(lw - ml);
        if (lane == 0) { float* SC = (float*)(P.ws + WS_SC); SC[u * 2] = aL; SC[u * 2 + 1] = ml; }
    }
#pragma unroll 1
    for (int it = 0; it < 8; ++it) {
        const int row = it * 8 + (lane >> 3), d0 = 16 * (lane & 7); float kv[16];
        bf16* kq = KQC + (size_t)(b * SEQ + tok0 + row) * DM + h * 128 + d0;
        conv16(P, l, b, tok0 + row, C_QKM + 512 + h * 128 + d0, 512 + h * 128 + d0, 0.08838834764831845f, kv);
        u32x4 w0, w1;
        w0.x = pk2(kv[0], kv[1]); w0.y = pk2(kv[2], kv[3]); w0.z = pk2(kv[4], kv[5]); w0.w = pk2(kv[6], kv[7]); w1.x = pk2(kv[8], kv[9]); w1.y = pk2(kv[10], kv[11]); w1.z = pk2(kv[12], kv[13]); w1.w = pk2(kv[14], kv[15]);
        *(u32x4*)(Kt + tb_off(row, d0)) = w0; *(u32x4*)(Kt + tb_off(row, d0 + 8)) = w1;
        *(u32x4*)(kq + 512) = w0; *(u32x4*)(kq + 520) = w1;
        conv16(P, l, b, tok0 + row, C_QKM + h * 128 + d0, h * 128 + d0, 1.0f, kv);
        w0.x = pk2(kv[0], kv[1]); w0.y = pk2(kv[2], kv[3]); w0.z = pk2(kv[4], kv[5]); w0.w = pk2(kv[6], kv[7]); w1.x = pk2(kv[8], kv[9]); w1.y = pk2(kv[10], kv[11]); w1.z = pk2(kv[12], kv[13]); w1.w = pk2(kv[14], kv[15]);
        *(u32x4*)(kq) = w0; *(u32x4*)(kq + 8) = w1;
    }
    LDS_WAIT();
    float* LC = (float*)(P.ws + WS_LC) + (size_t)u * 16384;
#pragma unroll 1
    for (int eb = 0; eb < 4; ++eb) {
#pragma unroll
        for (int it = 0; it < 4; ++it) { const int row = it * 16 + (lane >> 2), pc = lane & 3;
            const u32x4 x = *(const u32x4*)(PROJ + (size_t)(b * SEQ + tok0 + row) * PLD + C_VM + h * 128 + 32 * eb + 8 * pc); const float w = wS[row];
            u32x4 y; y.x = pk2(bf2f(x.x & 0xffffu) * w, bf2f(x.x >> 16) * w); y.y = pk2(bf2f(x.y & 0xffffu) * w, bf2f(x.y >> 16) * w); y.z = pk2(bf2f(x.z & 0xffffu) * w, bf2f(x.z >> 16) * w); y.w = pk2(bf2f(x.w & 0xffffu) * w, bf2f(x.w >> 16) * w);
            *(u32x4*)(Vb + row * 32 + 8 * pc) = y; }
        LDS_WAIT();
        f32x16 acc[4]; acc[0] = f32x16{}; acc[1] = f32x16{}; acc[2] = f32x16{}; acc[3] = f32x16{};
#pragma unroll
        for (int st = 0; st < 4; ++st) { const bf16x8 a = ldtr_nat(Vb, 0, 16 * st, lane);
#pragma unroll
            for (int db = 0; db < 4; ++db) acc[db] = mfma32(a, ldtr_nat(Kt, db, 16 * st, lane), acc[db]); }
#pragma unroll
        for (int db = 0; db < 4; ++db)
#pragma unroll
            for (int i = 0; i < 16; ++i) LC[(32 * eb + rowmap(i, hh)) * 128 + 32 * db + r32] = acc[db][i];
        LDS_WAIT();
    }
    {
        float n0 = 0.f, n1 = 0.f;
#pragma unroll 8
        for (int s = 0; s < 64; ++s) { const float w = wS[s]; n0 += w * bf2f(Kt[tb_off(s, lane)]); n1 += w * bf2f(Kt[tb_off(s, lane + 64)]); }
        float* NL = (float*)(P.ws + WS_NL) + (size_t)u * 128; NL[lane] = n0; NL[lane + 64] = n1;
    }
    LDS_WAIT();
}
__device__ __forceinline__ void mlstm_out_wave(const Params& P, unsigned char* ldsw, float* sc, int l, int uu, int lane) {
    const int u = uu >> 1, jt = uu & 1, bh = u >> 6, c = u & 63, b = bh >> 2, h = bh & 3, r32 = lane & 31, hh = lane >> 5, tok0 = 64 * c;
    bf16* Vt = (bf16*)ldsw; float* aS = sc; float* bS = sc + 64; float* GS = sc + 128;
    const float* GATES = (const float*)(P.ws + WS_GATES); const bf16* PROJ = (const bf16*)(P.ws + WS_PROJ); const bf16* KQC = (const bf16*)(P.ws + WS_XN);
    const float mprev = ((const float*)(P.ws + WS_MP))[u];
    {
        const float* gr = GATES + (size_t)(b * SEQ + tok0 + lane) * 32;
        const float lf = logsigmoidf_(gr[28 + h]), ig = gr[24 + h];
        const float a = wave_scan_add(lf, lane), bb = ig - a, pm = wave_scan_max(bb, lane);
        aS[lane] = a; bS[lane] = bb; GS[lane] = fmaxf(mprev, pm);
    }
    const int nrow = 32 * (jt + 1);
#pragma unroll 1
    for (int it = 0; it < nrow / 8; ++it) { const int row = it * 8 + (lane >> 3), d0 = 16 * (lane & 7);
        const bf16* vr = PROJ + (size_t)(b * SEQ + tok0 + row) * PLD + C_VM + h * 128 + d0;
        const u32x4 x0 = *(const u32x4*)vr, x1 = *(const u32x4*)(vr + 8);
        *(u32x4*)(Vt + tb_off(row, d0)) = x0; *(u32x4*)(Vt + tb_off(row, d0 + 8)) = x1; }
    LDS_WAIT();
    const int jl = 32 * jt + r32, trow = b * SEQ + tok0 + jl;
    bf16x8 qf[8];
    { const bf16* qrow = KQC + (size_t)trow * DM + h * 128 + 8 * hh;
#pragma unroll
        for (int st = 0; st < 8; ++st) qf[st] = ld8(qrow + 16 * st); }
    const float Gj = GS[jl], inter = __expf(mprev - Gj);
    float nq = 0.f;
    { const float* np = (const float*)(P.ws + WS_NP) + (size_t)u * 128 + 8 * hh;
#pragma unroll
        for (int st = 0; st < 8; ++st) { const f32x4 n0 = *(const f32x4*)(np + 16 * st), n1 = *(const f32x4*)(np + 16 * st + 4); const u32x4 qq = __builtin_bit_cast(u32x4, qf[st]);
            nq += n0[0] * bf2f(qq.x & 0xffffu) + n0[1] * bf2f(qq.x >> 16) + n0[2] * bf2f(qq.y & 0xffffu) + n0[3] * bf2f(qq.y >> 16)
                + n1[0] * bf2f(qq.z & 0xffffu) + n1[1] * bf2f(qq.z >> 16) + n1[2] * bf2f(qq.w & 0xffffu) + n1[3] * bf2f(qq.w >> 16); }
        nq += __shfl_xor(nq, 32); }
    bf16x8 pb[2][2]; float colsum = 0.f;
#pragma unroll
    for (int kt = 0; kt < 2; ++kt) {
        f32x16 sd = {};
        if (kt <= jt) {
            const bf16* krow = KQC + (size_t)(b * SEQ + tok0 + 32 * kt + r32) * DM + 512 + h * 128 + 8 * hh;
#pragma unroll
            for (int st = 0; st < 8; ++st) sd = mfma32(ld8(krow + 16 * st), qf[st], sd);
#pragma unroll
            for (int i = 0; i < 16; ++i) { const int s = 32 * kt + rowmap(i, hh); const float bsv = bS[s]; const float ev = __builtin_amdgcn_exp2f((bsv - Gj) * LOG2E); const float dv = (s <= jl) ? ev : 0.f; sd[i] *= dv; colsum += sd[i]; }
        }
        pb[kt][0] = pack8(sd, 0); pb[kt][1] = pack8(sd, 1);
        asm volatile("" ::: "memory");
    }
    f32x16 acc[4];
#pragma unroll
    for (int et = 0; et < 4; ++et) { acc[et] = f32x16{};
        const bf16* cp = (const bf16*)(P.ws + WS_CP) + (size_t)u * 16384 + (32 * et + r32) * 128 + 8 * hh;
#pragma unroll
        for (int st = 0; st < 8; ++st) acc[et] = mfma32(ld8(cp + 16 * st), qf[st], acc[et]);
#pragma unroll
        for (int i = 0; i < 16; ++i) acc[et][i] *= inter;
#pragma unroll
        for (int kt = 0; kt < 2; ++kt) { if (kt <= jt) {
#pragma unroll
            for (int s2 = 0; s2 < 2; ++s2) { const bf16* vb_ = Vt + et * 2048 + (32 * kt + 16 * s2 + 4 * hh + ((r32 & 15) >> 2)) * 32 + 16 * (r32 >> 4) + 4 * (r32 & 3);
                acc[et] = mfma32(ldtr8(vb_), pb[kt][s2], acc[et]); } } }
        asm volatile("" ::: "memory"); }
    colsum += __shfl_xor(colsum, 32);
    const float den = inter * nq + colsum, dn = fmaxf(fabsf(den), __expf(-(aS[jl] + Gj))), rdn = 1.0f / dn;
    float part = 0.f;
#pragma unroll
    for (int et = 0; et < 4; ++et)
#pragma unroll
        for (int q = 0; q < 4; ++q) { const int e0 = 32 * et + 8 * q + 4 * hh;
            const u32x2 ov = *(const u32x2*)(PROJ + (size_t)trow * PLD + C_OM + h * 128 + e0);
            const float o0 = bf2f(ov.x & 0xffffu), o1 = bf2f(ov.x >> 16), o2 = bf2f(ov.y & 0xffffu), o3 = bf2f(ov.y >> 16);
            acc[et][4 * q] *= rdn * sigmoidf_(o0); acc[et][4 * q + 1] *= rdn * sigmoidf_(o1); acc[et][4 * q + 2] *= rdn * sigmoidf_(o2); acc[et][4 * q + 3] *= rdn * sigmoidf_(o3);
            part += acc[et][4 * q] * acc[et][4 * q] + acc[et][4 * q + 1] * acc[et][4 * q + 1] + acc[et][4 * q + 2] * acc[et][4 * q + 2] + acc[et][4 * q + 3] * acc[et][4 * q + 3];
            if (q == 3) asm volatile("" ::: "memory"); }
    part += __shfl_xor(part, 32);
    const float rstd = rsqrtf(part * (1.0f / 128.0f) + EPSN);
    const float* ng = P.in[13] + (size_t)l * 512 + h * 128; bf16* Y = (bf16*)(P.ws + WS_Y) + (size_t)trow * DM + 512 + h * 128;
#pragma unroll
    for (int et = 0; et < 4; ++et)
#pragma unroll
        for (int q = 0; q < 4; ++q) { const int e0 = 32 * et + 8 * q + 4 * hh; const f32x4 gg = *(const f32x4*)(ng + e0);
            u32x2 w; w.x = pk2(acc[et][4 * q] * rstd * gg[0], acc[et][4 * q + 1] * rstd * gg[1]); w.y = pk2(acc[et][4 * q + 2] * rstd * gg[2], acc[et][4 * q + 3] * rstd * gg[3]);
            *(u32x2*)(Y + e0) = w; }
    LDS_WAIT();
}

constexpr int AL_KSC = 0, AL_KS = 36864, AL_VT = 73728, AL_IMPM = 36864, AL_IMPS = 53248, AL_SELB = 106496;
template <int MODE>
__device__ __forceinline__ void attn_tile(const bf16* Kt_, const bf16* Vt_, const bf16x8 (&qf)[4], f32x16 (&o)[2], float& m, float& l, float invl, int t, float slope2,
                                          int pos0, int posmul, bool lane_sel, float* IMPm, float* IMPs, int tokl, int jb, int r32, int hh) {
    f32x16 s[2]; s[0] = f32x16{}; s[1] = f32x16{};
#pragma unroll
    for (int st = 0; st < 4; ++st) { s[0] = mfma32(ld8(Kt_ + r32 * 72 + 16 * st + 8 * hh), qf[st], s[0]); s[1] = mfma32(ld8(Kt_ + (32 + r32) * 72 + 16 * st + 8 * hh), qf[st], s[1]); }
    const float C1 = 0.125f * LOG2E;
    float mx = -1.0e30f;
#pragma unroll
    for (int kt = 0; kt < 2; ++kt)
#pragma unroll
        for (int i = 0; i < 16; ++i) { const int keyl = 32 * kt + rowmap(i, hh); const int dist = t - (pos0 + posmul * keyl);
            bool valid = dist >= 0; if (MODE == 3) valid = valid && dist < 512; if (MODE == 2) valid = valid && lane_sel;
            const float v = valid ? (s[kt][i] * C1 - slope2 * (float)dist) : -1.0e30f; s[kt][i] = v; mx = fmaxf(mx, v); }
    if (MODE != 1) {
        mx = fmaxf(mx, __shfl_xor(mx, 32));
        const float mn = fmaxf(m, mx), alpha = __builtin_amdgcn_exp2f(m - mn); m = mn; l *= alpha;
        if (MODE >= 2) {
#pragma unroll
            for (int i = 0; i < 16; ++i) { o[0][i] *= alpha; o[1][i] *= alpha; } }
    }
    float ps = 0.f;
#pragma unroll
    for (int kt = 0; kt < 2; ++kt)
#pragma unroll
        for (int i = 0; i < 16; ++i) { const float v = s[kt][i]; float p = (v > -1.0e29f) ? __builtin_amdgcn_exp2f(v - m) : 0.f; if (MODE == 1) p *= invl; s[kt][i] = p; ps += p; }
    if (MODE != 1) l += ps;
    if (MODE == 0) return;
#pragma unroll
    for (int kt = 0; kt < 2; ++kt)
#pragma unroll
        for (int s2 = 0; s2 < 2; ++s2) { const bf16x8 pb = pack8(s[kt], s2);
            const bf16* vb_ = Vt_ + (32 * kt + 16 * s2 + 4 * hh + ((r32 & 15) >> 2)) * 32 + 16 * (r32 >> 4) + 4 * (r32 & 3);
            o[0] = mfma32(ldtr8(vb_), pb, o[0]);
            o[1] = mfma32(ldtr8(vb_ + 2048), pb, o[1]); }
    if (MODE == 1) {
#pragma unroll
        for (int kt = 0; kt < 2; ++kt)
#pragma unroll
            for (int q4 = 0; q4 < 4; ++q4) { float pp[4];
#pragma unroll
                for (int k = 0; k < 4; ++k) { float x = s[kt][4 * q4 + k]; x += __shfl_xor(x, 8); x += __shfl_xor(x, 16); pp[k] = x; }
                if (r32 < 8) { const int j = jb + 8 * kt + 2 * q4 + hh; IMPm[tokl * 64 + j] = pp[0] + pp[1] + pp[2] + 0.5f * pp[3]; if (j + 1 < 64) IMPs[tokl * 64 + j + 1] = 0.5f * pp[3]; } }
    }
}

__device__ __forceinline__ void attn_tile2(const bf16* Kt_, const bf16* Vt_, const bf16x8 (&qf)[4], f32x16 (&o)[2], float& m, float& l, int t, float slope2, int pos0, int maskmode, bool lane_sel, int r32, int hh) {
    f32x16 s[2]; s[0] = f32x16{}; s[1] = f32x16{};
    {
        bf16x8 kf[8];
#pragma unroll
        for (int st = 0; st < 4; ++st) { kf[2 * st] = ld8(Kt_ + r32 * 72 + 16 * st + 8 * hh); kf[2 * st + 1] = ld8(Kt_ + (32 + r32) * 72 + 16 * st + 8 * hh); }
        __builtin_amdgcn_sched_barrier(0);
#pragma unroll
        for (int st = 0; st < 4; ++st) { s[0] = mfma32(kf[2 * st], qf[st], s[0]); s[1] = mfma32(kf[2 * st + 1], qf[st], s[1]); }
    }
    bf16x8 vf[2][2][2];
#pragma unroll
    for (int kt = 0; kt < 2; ++kt)
#pragma unroll
        for (int s2 = 0; s2 < 2; ++s2) { const bf16* vb_ = Vt_ + (32 * kt + 16 * s2 + 4 * hh + ((r32 & 15) >> 2)) * 32 + 16 * (r32 >> 4) + 4 * (r32 & 3); vf[kt][s2][0] = ldtr8(vb_); vf[kt][s2][1] = ldtr8(vb_ + 2048); }
    __builtin_amdgcn_sched_barrier(0);
    const float C1 = 0.125f * LOG2E;
    const int dbi = t - pos0 - 4 * hh;
    const float b0 = lane_sel ? (-slope2 * (float)dbi - m) : -1.0e30f;
#pragma unroll
    for (int kt = 0; kt < 2; ++kt)
#pragma unroll
        for (int i = 0; i < 16; ++i) { const int cst = 32 * kt + (i & 3) + 8 * (i >> 2); s[kt][i] = fmaf(s[kt][i], C1, fmaf(slope2, (float)cst, b0)); }
    if (maskmode == 1) {
#pragma unroll
        for (int kt = 0; kt < 2; ++kt)
#pragma unroll
            for (int i = 0; i < 16; ++i) { const int cst = 32 * kt + (i & 3) + 8 * (i >> 2); s[kt][i] = (cst <= dbi) ? s[kt][i] : -1.0e30f; }
    } else if (maskmode == 2) {
#pragma unroll
        for (int kt = 0; kt < 2; ++kt)
#pragma unroll
            for (int i = 0; i < 16; ++i) { const int cst = 32 * kt + (i & 3) + 8 * (i >> 2); s[kt][i] = (dbi - cst < 512) ? s[kt][i] : -1.0e30f; }
    }
    float mx = -1.0e30f;
#pragma unroll
    for (int i = 0; i < 16; ++i) mx = fmaxf(mx, fmaxf(s[0][i], s[1][i]));
    mx = fmaxf(mx, __shfl_xor(mx, 32));
    if (__any(mx > 0.f)) {
        const float dl = fmaxf(mx, 0.f), alpha = __builtin_amdgcn_exp2f(-dl); m += dl; l *= alpha;
#pragma unroll
        for (int i = 0; i < 16; ++i) { o[0][i] *= alpha; o[1][i] *= alpha; s[0][i] -= dl; s[1][i] -= dl; }
    }
    float ps = 0.f;
#pragma unroll
    for (int kt = 0; kt < 2; ++kt)
#pragma unroll
        for (int i = 0; i < 16; ++i) { const float p = __builtin_amdgcn_exp2f(s[kt][i]); s[kt][i] = p; ps += p; }
    l += ps;
#pragma unroll
    for (int kt = 0; kt < 2; ++kt)
#pragma unroll
        for (int s2 = 0; s2 < 2; ++s2) { const bf16x8 pb = pack8(s[kt], s2);
            o[0] = mfma32(vf[kt][s2][0], pb, o[0]);
            o[1] = mfma32(vf[kt][s2][1], pb, o[1]); }
}

__device__ __forceinline__ void attn_unit(const Params& P, unsigned char* lds, int l, int uid, int tid) {
    asm volatile("" : "+v"(tid));
    const int qt = uid >> 3, b = (uid >> 1) & 3, g = uid & 1, cur = qt;
    const int wave = tid >> 6, lane = tid & 63, r32 = lane & 31, hh = lane >> 5, tl = r32 & 7, r = r32 >> 3, tokl = 8 * wave + tl, t = 64 * qt + tokl, hd = 4 * g + r;
    const float slope2 = __builtin_amdgcn_exp2f(-(float)(hd + 1)) * LOG2E;
    bf16* KsC = (bf16*)(lds + AL_KSC); bf16* Ks = (bf16*)(lds + AL_KS); bf16* Vt = (bf16*)(lds + AL_VT);
    float* IMPm = (float*)(lds + AL_IMPM); float* IMPs = (float*)(lds + AL_IMPS); unsigned char* selb = lds + AL_SELB;
    const bf16* PROJ = (const bf16*)(P.ws + WS_PROJ); const float* GATES = (const float*)(P.ws + WS_GATES);
    const bf16* KCk = (const bf16*)(P.ws + WS_KC) + (size_t)((0 * 4 + b) * 2 + g) * 256 * 64; const bf16* KCv = (const bf16*)(P.ws + WS_KC) + (size_t)((1 * 4 + b) * 2 + g) * 256 * 64;
    const int lrow = tid >> 3, lch = tid & 7;
    for (int i = tid; i < 8192; i += NTHR) IMPm[i] = 0.f;
    bf16x8 qf[4];
    { const bf16* qrow = PROJ + (size_t)(b * SEQ + t) * PLD + C_QN + hd * 64 + 8 * hh;
#pragma unroll
        for (int st = 0; st < 4; ++st) qf[st] = ld8(qrow + 16 * st); }
    const float* grow = GATES + (size_t)(b * SEQ + t) * 32 + g * 12 + r * 3;
    const float gate_c = sigmoidf_(grow[0]), gate_s = sigmoidf_(grow[1]), gate_w = sigmoidf_(grow[2]);
    f32x16 outacc[2]; outacc[0] = f32x16{}; outacc[1] = f32x16{};
    f32x16 o[2];
    const int ntile = (4 * qt + 3 + 63) >> 6;
    for (int tile = 0; tile < ntile; ++tile) *(u32x4*)(KsC + tile * 4608 + lrow * 72 + lch * 8) = *(const u32x4*)(KCk + (size_t)(tile * 64 + lrow) * 64 + lch * 8);
    u32x4 vreg = *(const u32x4*)(KCv + (size_t)lrow * 64 + lch * 8), kreg = {0u, 0u, 0u, 0u};
#define VT_WRITE(buf, reg) (*(u32x4*)(Vt + (buf) * 4096 + (lch >> 2) * 2048 + lrow * 32 + (lch & 3) * 8) = (reg))
#define KS_WRITE(buf, reg) (*(u32x4*)(Ks + (buf) * 4608 + lrow * 72 + lch * 8) = (reg))
    VT_WRITE(0, vreg);
    __syncthreads();
    float m_c = -1.0e30f, l_c = 0.f;
    for (int tile = 0; tile < ntile; ++tile) attn_tile<0>(KsC + tile * 4608, nullptr, qf, o, m_c, l_c, 0.f, t, slope2, 1024 * tile + 31, 16, true, IMPm, IMPs, tokl, 16 * tile, r32, hh);
    { const float lt = l_c + __shfl_xor(l_c, 32); const float invl = lt > 0.f ? 1.0f / lt : 0.f;
        o[0] = f32x16{}; o[1] = f32x16{};
        for (int tile = 0; tile < ntile; ++tile) {
            if (tile + 1 < ntile) vreg = *(const u32x4*)(KCv + (size_t)((tile + 1) * 64 + lrow) * 64 + lch * 8);
            attn_tile<1>(KsC + tile * 4608, Vt + (tile & 1) * 4096, qf, o, m_c, l_c, invl, t, slope2, 1024 * tile + 31, 16, true, IMPm, IMPs, tokl, 16 * tile, r32, hh);
            if (tile + 1 < ntile) VT_WRITE((tile + 1) & 1, vreg);
            __syncthreads();
        }
#pragma unroll
        for (int i = 0; i < 16; ++i) { outacc[0][i] = gate_c * o[0][i]; outacc[1][i] = gate_c * o[1][i]; }
    }
    {
        const int tok = tid >> 3, sub = tid & 7; float vv[8];
#pragma unroll
        for (int k = 0; k < 8; ++k) { const int j = sub * 8 + k; float v = IMPm[tok * 64 + j] + IMPs[tok * 64 + j];
            if (j == 0 || j == cur || j == cur - 1) v += 1.0e4f;
            if (j > cur) v = -1.0f;
            vv[k] = v; }
#pragma unroll
        for (int k = 0; k < 8; ++k) IMPm[tok * 64 + sub * 8 + k] = vv[k];
        __syncthreads();
        unsigned bits = 0u;
#pragma unroll
        for (int k = 0; k < 8; ++k) { const int j = sub * 8 + k; int rank = 0;
#pragma unroll 4
            for (int j2 = 0; j2 < 64; ++j2) { const float x = IMPm[tok * 64 + j2]; rank += (x > vv[k] || (x == vv[k] && j2 < j)) ? 1 : 0; }
            if (rank < 16 && j <= cur) bits |= 1u << k; }
        selb[tok * 8 + sub] = (unsigned char)bits;
        __syncthreads();
    }
    const unsigned sel_lo = *(const unsigned*)(selb + tokl * 8), sel_hi = *(const unsigned*)(selb + tokl * 8 + 4);
    unsigned long long uni;
    { unsigned ulo = *(const unsigned*)(selb + lane * 8), uhi = *(const unsigned*)(selb + lane * 8 + 4);
#pragma unroll
        for (int of = 1; of < 64; of <<= 1) { ulo |= __shfl_xor(ulo, of); uhi |= __shfl_xor(uhi, of); }
        uni = ((unsigned long long)(unsigned)__builtin_amdgcn_readfirstlane(uhi) << 32) | (unsigned)__builtin_amdgcn_readfirstlane(ulo); }
    {
        unsigned long long it_uni = uni; int it_wj = cur; const int jlo = cur - 8 < 0 ? 0 : cur - 8;
#define TNEXT(dst) do { if (it_uni) { const int j_ = 63 - __builtin_clzll(it_uni); it_uni &= ~(1ull << j_); dst = j_; } else if (it_wj >= jlo) { dst = 256 + it_wj; --it_wj; } else dst = -1; } while (0)
#define TLOAD(kr, vr, code) do { const int br_ = (code) >> 8, j_ = (code) & 255; const bf16* rp_ = PROJ + (size_t)(b * SEQ + 64 * j_ + lrow) * PLD + C_KV + (2 + 2 * br_) * 128 + g * 64 + lch * 8; \
        kr = *(const u32x4*)rp_; vr = *(const u32x4*)(rp_ + 128); } while (0)
        float m_r = 0.f, l_r = 0.f; o[0] = f32x16{}; o[1] = f32x16{}; bool in_win = false;
#define TCOMPUTE(buf, code) do { const int br_ = (code) >> 8, j_ = (code) & 255; \
        if (br_ && !in_win) { in_win = true; const float lt_ = l_r + __shfl_xor(l_r, 32); const float sc_ = lt_ > 0.f ? gate_s / lt_ : 0.f; \
            _Pragma("unroll") for (int i = 0; i < 16; ++i) { outacc[0][i] += sc_ * o[0][i]; outacc[1][i] += sc_ * o[1][i]; } \
            m_r = 0.f; l_r = 0.f; o[0] = f32x16{}; o[1] = f32x16{}; } \
        if (br_) attn_tile2(Ks + (buf) * 4608, Vt + (buf) * 4096, qf, o, m_r, l_r, t, slope2, 64 * j_, (j_ == cur) ? 1 : ((j_ == cur - 8) ? 2 : 0), true, r32, hh); \
        else { const bool lsel_ = (j_ < 32 ? (sel_lo >> j_) : (sel_hi >> (j_ - 32))) & 1u; \
            if (__any(lsel_)) attn_tile2(Ks + (buf) * 4608, Vt + (buf) * 4096, qf, o, m_r, l_r, t, slope2, 64 * j_, (j_ == cur) ? 1 : 0, lsel_, r32, hh); } } while (0)
        const u32x4 z4 = {0u, 0u, 0u, 0u};
        u32x4 kA0, vA0, kA1 = z4, vA1 = z4, kB0 = z4, vB0 = z4, kB1 = z4, vB1 = z4;
        int c0, c1, n0, n1, nn0, nn1, t0_, t1_;
#define TLOAD2(k0, v0, k1, v1, a, b_) do { if ((a) >= 0) TLOAD(k0, v0, a); if ((b_) >= 0) TLOAD(k1, v1, b_); } while (0)
#define TWRITE2(st, k0, v0, k1, v1, a, b_) do { if ((a) >= 0) { KS_WRITE(2 * (st), k0); VT_WRITE(2 * (st), v0); } if ((b_) >= 0) { KS_WRITE(2 * (st) + 1, k1); VT_WRITE(2 * (st) + 1, v1); } } while (0)
        TNEXT(c0); TNEXT(c1); TNEXT(n0); TNEXT(n1);
        TLOAD2(kA0, vA0, kA1, vA1, c0, c1); TLOAD2(kB0, vB0, kB1, vB1, n0, n1);
        TWRITE2(0, kA0, vA0, kA1, vA1, c0, c1);
        __syncthreads();
        TNEXT(nn0); TNEXT(nn1); TLOAD2(kA0, vA0, kA1, vA1, nn0, nn1);
        for (;;) {
            TCOMPUTE(0, c0); if (c1 >= 0) TCOMPUTE(1, c1);
            TWRITE2(1, kB0, vB0, kB1, vB1, n0, n1);
            __syncthreads();
            if (n0 < 0) break;
            TNEXT(t0_); TNEXT(t1_); TLOAD2(kB0, vB0, kB1, vB1, t0_, t1_);
            c0 = n0; c1 = n1; n0 = nn0; n1 = nn1; nn0 = t0_; nn1 = t1_;
            TCOMPUTE(2, c0); if (c1 >= 0) TCOMPUTE(3, c1);
            TWRITE2(0, kA0, vA0, kA1, vA1, n0, n1);
            __syncthreads();
            if (n0 < 0) break;
            TNEXT(t0_); TNEXT(t1_); TLOAD2(kA0, vA0, kA1, vA1, t0_, t1_);
            c0 = n0; c1 = n1; n0 = nn0; n1 = nn1; nn0 = t0_; nn1 = t1_;
        }
#undef TLOAD2
#undef TWRITE2
        { const float lt = l_r + __shfl_xor(l_r, 32); const float sc = lt > 0.f ? gate_w / lt : 0.f;
#pragma unroll
            for (int i = 0; i < 16; ++i) { outacc[0][i] += sc * o[0][i]; outacc[1][i] += sc * o[1][i]; } }
#undef TNEXT
#undef TLOAD
#undef TCOMPUTE
    }
#undef VT_WRITE
#undef KS_WRITE
    bf16* Y = (bf16*)(P.ws + WS_Y) + (size_t)(b * SEQ + t) * DM + hd * 64;
#pragma unroll
    for (int db = 0; db < 2; ++db)
#pragma unroll
        for (int q4 = 0; q4 < 4; ++q4) { u32x2 w; w.x = pk2(outacc[db][4 * q4], outacc[db][4 * q4 + 1]); w.y = pk2(outacc[db][4 * q4 + 2], outacc[db][4 * q4 + 3]);
            *(u32x2*)(Y + 32 * db + 8 * q4 + 4 * hh) = w; }
}

#ifndef EXP_DUP
#define EXP_DUP -1
#endif
constexpr int N_PHASES = 21;
constexpr int MGU_A = MGU_P + 2624, MGU_B = MGU_A + 2560;
__global__ void __launch_bounds__(NTHR, 2) hybrid_fwd(Params P) {
    extern __shared__ __attribute__((aligned(16))) unsigned char lds[];
    cg::grid_group grid = cg::this_grid();
    const int G = gridDim.x, bx0 = blockIdx.x, NGW = G * NWAVES;
    const int wave0 = __builtin_amdgcn_readfirstlane((int)threadIdx.x >> 6);
#define IDS() int lane_; asm volatile("v_mbcnt_lo_u32_b32 %0, -1, 0\n\tv_mbcnt_hi_u32_b32 %0, -1, %0" : "=v"(lane_)); int wave_ = wave0, bx_ = bx0; asm volatile("" : "+s"(wave_), "+s"(bx_)); const int wave = wave_, bx = bx_, lane = lane_, tid = wave * 64 + lane, gw = bx * NWAVES + wave; (void)gw
    unsigned char* ws = P.ws;
    PG8_LAS unsigned char* glds = (PG8_LAS unsigned char*)lds;
#ifndef ONLY_KIND
#define ONLY_KIND -1
#endif
#ifndef ONLY_MASK
#define ONLY_MASK 0
#endif
#define KIND(x) ((ONLY_KIND < 0 && ONLY_MASK == 0) || ONLY_KIND == (x) || ((ONLY_MASK >> (x)) & 1))
#ifndef EXP_DUP
#define EXP_DUP -1
#endif
#define REPS(x) for (int rep_ = 0, nrep_ = ((EXP_DUP == (x)) ? 2 : 1); rep_ < nrep_; ++rep_)
#define RUN(k) (P.ph_lo <= (k) && (k) < P.ph_hi)
    if (threadIdx.x < 2) ((volatile LAS unsigned*)((LAS unsigned char*)lds + LDS_BAR_ST))[threadIdx.x] = 0u;
    __syncthreads();
    XcdBarrier xbar = xcd_barrier_post((unsigned*)(ws + WS_CTL) + CW_BAR + P.li * XCD_BAR_WORDS, (volatile LAS unsigned*)((LAS unsigned char*)lds + LDS_BAR_ST));
    if (P.ph_lo < 0) grid.sync();
#define SEAM(k) do { if (RUN(k) && RUN((k) + 1)) xcd_barrier(xbar); } while (0)
    if (RUN(0) && KIND(0)) { IDS(); REPS(0) prologue(P, lds, gw, NGW, wave, lane); }
    SEAM(0);
    for (int l = 0; l < 2; ++l) {
        const int pb = 1 + 9 * l;
        const float* xin = (l == 0) ? P.in[0] : P.out;
        if (RUN(pb + 0) && KIND(1)) { IDS(); REPS(1) rowpass<false>(P, lds, xin, P.in[4] + l * DM, l, 0, 1024, bx, G, tid, wave, lane); mod_finalize(P, l, bx, tid); }
        SEAM(pb + 0);
        if (RUN(pb + 1) && KIND(2)) { IDS();
            pg8::Gemm g{(const pg8::bf16_t*)(ws + WS_XN), (const pg8::bf16_t*)(ws + WS_WIN) + (size_t)l * NPROJ * DM, M, NPROJ, DM, 0, DM};
            pg8::StaticOrder S; S.init(M, NPROJ, G, bx);
            EpiProj E{(bf16*)(ws + WS_PROJ), (float*)(ws + WS_GATES), (const float*)(ws + WS_BIASP) + l * NPROJ};
            REPS(2) pg8::gemm_phase<EpiProj, pg8::StaticOrder, true, true>(glds, g, S, E, tid);
            if (G == 256 && bx >= 128) conv_moe_gu_items(P, (bf16*)(lds + wave * 16384), l == 0 ? MGU_P : MGU_B, l == 0 ? MGU_A : MGU_ITEMS, (bx - 128) * NWAVES + wave, 128 * NWAVES, lane);
            else if (G != 256 && l == 0) conv_moe_gu_items(P, (bf16*)(lds + wave * 16384), MGU_P, MGU_ITEMS, gw, NGW, lane);
        }
        SEAM(pb + 1);
        if (RUN(pb + 2)) { IDS();
            bf16* dscr = (bf16*)(lds + LDS_DCONV + wave * 9216);
            if (KIND(3)) REPS(3) for (int u = bx; u < 256; u += G) { CItem it = {nullptr, nullptr, 0, 0, 0}; f32x4 cv[16]; const bool hv = (l == 0) && ditem_decode(P, u * 8 + wave, lane, it); if (hv) conv_issue(it, cv); else conv_zero(cv);
                compress_unit(P, lds, l, u, tid); if (hv) conv_finish(it, cv, dscr, lane); }
            if (KIND(4)) REPS(4) for (int u = bx; u < 1024; u += G) { CItem it = {nullptr, nullptr, 0, 0, 0}; f32x4 cv[16]; const bool hv = (l == 0) && ditem_decode(P, 2048 + u * 8 + wave, lane, it); if (hv) conv_issue(it, cv); else conv_zero(cv);
                mlstm_local_unit(P, lds, l, u, tid); if (hv) conv_finish(it, cv, dscr, lane); }
        }
        SEAM(pb + 2);
        if (RUN(pb + 3)) { IDS();
            if (KIND(5)) REPS(5) mlstm_scan(P, bx * NTHR + tid, G * NTHR);
            if (KIND(6)) REPS(6) for (int u0 = bx; u0 < 256; u0 += G) { attn_unit(P, lds, l, u0, tid); attn_unit(P, lds, l, 511 - u0, tid); }
        }
        SEAM(pb + 3);
        if (RUN(pb + 4) && KIND(7)) { IDS(); REPS(7) for (int uu = gw; uu < 2048; uu += NGW) mlstm_out_wave(P, lds + wave * 16384, (float*)(lds + 131072 + 512 + wave * 1024), l, uu, lane); __syncthreads(); }
        SEAM(pb + 4);
        if (RUN(pb + 5) && KIND(8)) { IDS();
            pg8::Gemm g{(const pg8::bf16_t*)(ws + WS_Y), (const pg8::bf16_t*)(ws + WS_WOUT) + (size_t)l * DM * DM, M, DM, DM, 0, DM};
            pg8::StaticOrder S; S.init(M, DM, G, bx);
            REPS(8) { EpiRes E{xin, (rep_ + 1 < nrep_) ? (float*)(ws + WS_XG) : P.out, (const float*)(ws + WS_MODF), l, 2048};
            pg8::gemm_phase<EpiRes, pg8::StaticOrder, true, true>(glds, g, S, E, tid); }
        }
        SEAM(pb + 5);
        if (RUN(pb + 6) && KIND(9)) { IDS(); if (l == 0) rowpass<false>(P, lds, P.out, P.in[5], 0, 3072, 4096, bx, G, tid, wave, lane); else rowpass<true>(P, lds, P.out, P.in[5] + DM, 1, 3072, 4096, bx, G, tid, wave, lane); }
        SEAM(pb + 6);
        if (l == 0) {
            if (RUN(pb + 7) && KIND(10)) { IDS();
                pg8::Gemm g{(const pg8::bf16_t*)(ws + WS_XN), (const pg8::bf16_t*)(ws + WS_WGU), M, 2 * DFF, DM, 0, DM};
                pg8::StaticOrder S; S.init(M, 2 * DFF, G, bx);
                EpiSwiglu E{(bf16*)(ws + WS_HB), DFF};
                REPS(10) pg8::gemm_phase<EpiSwiglu, pg8::StaticOrder, true, true>(glds, g, S, E, tid);
                if (G == 256 && bx >= 128) conv_moe_gu_items(P, (bf16*)(lds + wave * 16384), MGU_A, MGU_B, (bx - 128) * NWAVES + wave, 128 * NWAVES, lane);
            }
            SEAM(pb + 7);
            if (RUN(pb + 8) && KIND(11)) { IDS();
                pg8::Gemm g{(const pg8::bf16_t*)(ws + WS_HB), (const pg8::bf16_t*)(ws + WS_WDN), M, DM, DFF, 0, DFF};
                pg8::StaticOrder S; S.init(M, DM, G, bx);
                REPS(11) { EpiRes E{P.out, (rep_ + 1 < nrep_) ? (float*)(ws + WS_XG) : P.out, (const float*)(ws + WS_MODF), 0, 5120};
                pg8::gemm_phase<EpiRes, pg8::StaticOrder, true, true>(glds, g, S, E, tid); }
            }
            SEAM(pb + 8);
        } else {
            if (RUN(pb + 7) && KIND(12)) { IDS(); moe_scatter(P, lds, bx, G, tid, wave, lane); conv_moe_dn_items(P, (bf16*)(lds + wave * 16384), gw, NGW, lane); }
            SEAM(pb + 7);
            if (RUN(pb + 8) && KIND(13)) { IDS();
                pg8::Gemm g{(const pg8::bf16_t*)(ws + WS_XG), (const pg8::bf16_t*)(ws + WS_MOE_GU), MAXR, 2 * DFFE, DM, (size_t)2 * DFFE * DM * 2, DM};
                MoeOrder S; S.init((const unsigned*)(ws + WS_CTL) + CW_CNT, 28, G, bx);
                EpiSwiglu E{(bf16*)(ws + WS_HG), DFFE};
                REPS(13) pg8::gemm_phase<EpiSwiglu, MoeOrder, true, true>(glds, g, S, E, tid);
            }
            SEAM(pb + 8);
            if (RUN(pb + 9) && KIND(14)) { IDS();
                MoeOrder S; S.init((const unsigned*)(ws + WS_CTL) + CW_CNT, 4, G, bx);
                const int total = S.total(), full = (total / G) * G, rest = total - full; const bool splitk = rest > 0 && rest <= 32;
                S.hi = splitk ? full : total;
                {   pg8::Gemm g{(const pg8::bf16_t*)(ws + WS_HG), (const pg8::bf16_t*)(ws + WS_MOE_DN), MAXR, DM, DFFE, (size_t)DM * DFFE * 2, DFFE};
                    EpiF32 E{(float*)(ws + WS_YG)};
                    REPS(14) pg8::gemm_phase<EpiF32, MoeOrder, true, true>(glds, g, S, E, tid); }
                if (splitk) {
                    MoeOrderT<4> S2; S2.init((const unsigned*)(ws + WS_CTL) + CW_CNT, 4, G, bx); S2.lo = full; S2.hi = total; S2.kpart = DFFE / 4;
                    pg8::Gemm g{(const pg8::bf16_t*)(ws + WS_HG), (const pg8::bf16_t*)(ws + WS_MOE_DN), MAXR, DM, DFFE / 4, (size_t)DM * DFFE * 2, DFFE};
                    EpiPart E{(float*)(ws + WS_PART)};
                    int lane2; asm volatile("v_mbcnt_lo_u32_b32 %0, -1, 0\n\tv_mbcnt_hi_u32_b32 %0, -1, %0" : "=v"(lane2));
                    pg8::gemm_phase<EpiPart, MoeOrderT<4>, true, true>(glds, g, S2, E, wave * 64 + lane2);
                    xcd_barrier(xbar);
                    int lane3; asm volatile("v_mbcnt_lo_u32_b32 %0, -1, 0\n\tv_mbcnt_hi_u32_b32 %0, -1, %0" : "=v"(lane3)); const int tid3 = wave * 64 + lane3;
                    const float* PART = (const float*)(ws + WS_PART); float* YG = (float*)(ws + WS_YG);
                    for (int idx = bx * NTHR + tid3; idx < rest * 16384; idx += G * NTHR) {
                        const int r = idx >> 14, w = idx & 16383, row = w >> 6, c4 = (w & 63) * 4;
                        pg8::Unit uu; MoeOrder S3 = S; S3.lo = full + r; S3.hi = full + r + 1; S3.c = 0; S3.next(0, uu);
                        const float* pp = PART + (size_t)(r * 4) * 65536 + row * 256 + c4;
                        const f32x4 v = (*(const f32x4*)pp + *(const f32x4*)(pp + 65536)) + (*(const f32x4*)(pp + 2 * 65536) + *(const f32x4*)(pp + 3 * 65536));
                        *(f32x4*)(YG + (size_t)(uu.pm * 256 + row) * DM + uu.pn * 256 + c4) = v; }
                }
            }
            SEAM(pb + 9);
        }
    }
    if (RUN(20) && KIND(15)) { IDS(); moe_combine_final(P, lds, bx, G, tid, wave, lane); }
#undef RUN
#undef SEAM
}

extern "C" void kernel_launch(void* const* d_in, const int* in_sizes, int n_in, void* d_out, int out_size, void* d_ws, size_t ws_size, hipStream_t stream) {
    static int grid = 0;
    if (grid == 0) {
        if (n_in != 23 || out_size != M * DM || ws_size < WS_END) { fprintf(stderr, "kernel_launch: unexpected shapes (n_in %d out %d ws %zu, need %zu)\n", n_in, out_size, ws_size, (size_t)WS_END); grid = -1; return; }
        int dev = 0, cus = 0, per_cu = 0;
        hipGetDevice(&dev); hipDeviceGetAttribute(&cus, hipDeviceAttributeMultiprocessorCount, dev);
        hipFuncSetAttribute((const void*)hybrid_fwd, hipFuncAttributeMaxDynamicSharedMemorySize, LDS_BYTES);
        if (hipOccupancyMaxActiveBlocksPerMultiprocessor(&per_cu, (const void*)hybrid_fwd, NTHR, LDS_BYTES) != hipSuccess || per_cu < 1) { fprintf(stderr, "kernel_launch: occupancy query says %d\n", per_cu); per_cu = 1; }
        (void)hipGetLastError();
        grid = cus;
        if (grid <= 0) grid = 256;
    }
    if (grid < 0) return;
    hipMemsetAsync((char*)d_ws + WS_CTL, 0, CTL_ZERO_BYTES, stream);
    Params p{};
    for (int i = 0; i < 23; ++i) p.in[i] = (const float*)d_in[i];
    p.out = (float*)d_out; p.ws = (unsigned char*)d_ws;
#if MK_PER_PHASE
    for (int ph = 0; ph < N_PHASES; ++ph) { p.ph_lo = ph; p.ph_hi = ph + 1; void* args[] = {&p};
        hipError_t e = hipLaunchCooperativeKernel((const void*)hybrid_fwd, dim3(grid), dim3(NTHR), args, LDS_BYTES, stream);
        if (e != hipSuccess) { fprintf(stderr, "cooperative launch (phase %d) failed: %s\n", ph, hipGetErrorString(e)); break; } }
#elif defined(PROBE_PHASE)
    for (int li = 0; li < 2; ++li) { p.li = li; p.ph_lo = li == 0 ? 0 : PROBE_PHASE; p.ph_hi = li == 0 ? PROBE_PHASE + 1 : N_PHASES; void* args[] = {&p};
        hipError_t e = hipLaunchCooperativeKernel((const void*)hybrid_fwd, dim3(grid), dim3(NTHR), args, LDS_BYTES, stream);
        if (e != hipSuccess) { fprintf(stderr, "cooperative launch failed: %s\n", hipGetErrorString(e)); break; } }
#else
    p.ph_lo = 0; p.ph_hi = N_PHASES; void* args[] = {&p};
    hipError_t e = hipLaunchCooperativeKernel((const void*)hybrid_fwd, dim3(grid), dim3(NTHR), args, LDS_BYTES, stream);
    if (e != hipSuccess) fprintf(stderr, "cooperative launch failed: %s (grid %d)\n", hipGetErrorString(e), grid);
#endif
}
```

```cpp
#include <hip/hip_runtime.h>
#include <hip/hip_cooperative_groups.h>
#include <cstdio>
#include <cstdint>
namespace cg = cooperative_groups;
namespace pg8 {
#define PG8_LAS __attribute__((address_space(3)))
typedef unsigned short bf16_t;
typedef short bf16x8 __attribute__((ext_vector_type(8)));
typedef float f32x4 __attribute__((ext_vector_type(4)));
typedef unsigned u32x4 __attribute__((ext_vector_type(4)));
constexpr int BM = 256, BK = 64, HALF = 128, HTB = HALF * BK * 2  , STAGE_BYTES = 8 * HTB, NXCD = 8, WGM = 8;

__host__ __device__ __forceinline__ int lds_byte(int r, int c) { const int st = (r >> 4) * 2 + (c >> 5), rr = r & 15, cc = c & 31, ob = rr * 64 + cc * 2; return st * 1024 + (ob ^ (((ob >> 9) & 1) << 5)); }
__host__ __device__ __forceinline__ void stage_rc(int b, int& R, int& C) { const int st = b / 1024, sb = b % 1024, swz = sb ^ (((sb >> 9) & 1) << 5); R = (st >> 1) * 16 + swz / 64; C = (st & 1) * 32 + (swz % 64) / 2; }
__host__ __device__ __forceinline__ int perm32(int rho) { const int n = rho >> 4, i = rho & 15; return 8 * (i >> 2) + 4 * n + (i & 3); }

struct Unit { int pm, pn, e, koff, aux; };
struct Gemm { const bf16_t* A; const bf16_t* Bt; int M, N, K; size_t estride; int ld; };
struct StaticOrder {
    int nM, nN, nwg, G, c;
    __host__ __device__ void init(int M, int N, int G_, int c_) { nM = M / BM; nN = N / BM; nwg = nM * nN; G = G_; c = c_; }
    __host__ __device__ bool next(int i, Unit& u) const {
        const long L = (long)i * G + c; if (L >= nwg) return false;
        int wgid = (int)L; { const int q = nwg / NXCD, r = nwg % NXCD, xcd = wgid % NXCD, off = wgid / NXCD; wgid = (xcd < r ? xcd * (q + 1) : r * (q + 1) + (xcd - r) * q) + off; }
        const int nig = WGM * nN, gid = wgid / nig, fm = gid * WGM, gsz = (nM - fm) < WGM ? (nM - fm) : WGM;
        u.pm = fm + ((wgid % nig) % gsz); u.pn = (wgid % nig) / gsz; u.e = 0; u.koff = 0; u.aux = 0; return true;
    }
    __device__ __forceinline__ void a_ready(const Unit&) const {}
    __device__ __forceinline__ void done(const Unit&) const {}
};

__device__ __forceinline__ unsigned cvt_pk_bf16(float lo, float hi) { unsigned r; asm volatile("v_cvt_pk_bf16_f32 %0, %1, %2" : "=v"(r) : "v"(lo), "v"(hi)); return r; }
typedef float f32x2 __attribute__((ext_vector_type(2)));
template <class Epi, class Sched, bool ALIGN_EPI = false, bool SP2 = false>
__device__ __forceinline__ void gemm_phase(PG8_LAS unsigned char* lds, const Gemm g, const Sched& S, const Epi& E, int tid_) {
        const int tid = tid_, wid = __builtin_amdgcn_readfirstlane(tid >> 6), lane = tid & 63, wr = wid >> 2, wc = wid & 3, fr = lane & 15, fq = lane >> 4;
    const int K = g.K, nt = K / BK;
    unsigned voffA[2], voffB[2];
#pragma unroll
    for (int i = 0; i < 2; ++i) { int R, C; stage_rc(tid * 16 + i * 8192, R, C); const int Rb = Epi::PERM ? ((R & ~31) + perm32(R & 31)) : R;
        voffA[i] = (unsigned)(R * g.ld + C) * 2u; voffB[i] = (unsigned)(Rb * g.ld + C) * 2u; }
    const size_t kstep = (size_t)(BK * 2);
    const size_t hstep = (size_t)HALF * g.ld * 2;
    const size_t tstep = 2 * hstep;
    const unsigned ldsw = (unsigned)wid * 1024u;
    const int aoff = lds_byte(wr * 64 + fr, fq * 8), boff = lds_byte(wc * 32 + fr, fq * 8);
#define PG8_SA(b, h) (((b) * 2 + (h)) * HTB)
#define PG8_SB(b, h) ((4 + (b) * 2 + (h)) * HTB)
#define PG8_STAGE(bufoff, gbase, voff) do { _Pragma("unroll") for (int _i = 0; _i < 2; ++_i) \
        __builtin_amdgcn_global_load_lds((const unsigned*)((const char*)(gbase) + (voff)[_i]), (PG8_LAS unsigned*)(lds + (bufoff) + ldsw + _i * 8192), 16, 0, 0); } while (0)
#define PG8_LDA(dst, b, h) do { _Pragma("unroll") for (int m = 0; m < 4; ++m) _Pragma("unroll") for (int k = 0; k < 2; ++k) dst[m][k] = *(const PG8_LAS bf16x8*)(lds + PG8_SA(b, h) + aoff + m * 2048 + k * 1024); } while (0)
#define PG8_LDB(dst, b, h) do { _Pragma("unroll") for (int n = 0; n < 2; ++n) _Pragma("unroll") for (int k = 0; k < 2; ++k) dst[n][k] = *(const PG8_LAS bf16x8*)(lds + PG8_SB(b, h) + boff + n * 2048 + k * 1024); } while (0)
#define PG8_MMA(ai, bj, At, Bt) do { __builtin_amdgcn_s_setprio(1); _Pragma("unroll") for (int m = 0; m < 4; ++m) _Pragma("unroll") for (int n = 0; n < 2; ++n) _Pragma("unroll") for (int k = 0; k < 2; ++k) \
        acc[ai][bj][m][n] = __builtin_amdgcn_mfma_f32_16x16x32_bf16(Bt[n][k], At[m][k], acc[ai][bj][m][n], 0, 0, 0); __builtin_amdgcn_s_setprio(0); } while (0)
#define PG8_WAIT_V(n) asm volatile("s_waitcnt vmcnt(" #n ")" ::: "memory")
#define PG8_WAIT_L(n) asm volatile("s_waitcnt lgkmcnt(" #n ")" ::: "memory")
#define PG8_BAR __builtin_amdgcn_s_barrier()
#define PG8_SCHED __builtin_amdgcn_sched_barrier(0)
    Unit cur, nxt; int ui = 0;
    if (!S.next(0, cur)) return;
    f32x4 acc[2][2][4][2];
#pragma unroll
    for (int a = 0; a < 2; ++a)
#pragma unroll
        for (int b = 0; b < 2; ++b)
#pragma unroll
            for (int m = 0; m < 4; ++m)
#pragma unroll
                for (int n = 0; n < 2; ++n) acc[a][b][m][n] = (f32x4){0.f, 0.f, 0.f, 0.f};
    bf16x8 At[4][2], B0[2][2], B1[2][2];
    const char* cA = (const char*)g.A + (size_t)cur.pm * tstep + (size_t)cur.koff * 2; const char* cB = (const char*)g.Bt + (size_t)cur.pn * tstep + (size_t)cur.e * g.estride + (size_t)cur.koff * 2;
    S.a_ready(cur);
    if constexpr (SP2) {
        PG8_STAGE(PG8_SB(0, 0), cB, voffB); PG8_STAGE(PG8_SB(0, 1), cB + hstep, voffB); PG8_STAGE(PG8_SA(0, 0), cA, voffA); PG8_STAGE(PG8_SA(0, 1), cA + hstep, voffA);
        if (wr == 1) PG8_BAR;
        PG8_WAIT_V(2); PG8_BAR;
        PG8_STAGE(PG8_SB(1, 0), cB + kstep, voffB); PG8_STAGE(PG8_SA(1, 0), cA + kstep, voffA); PG8_STAGE(PG8_SB(1, 1), cB + hstep + kstep, voffB);
        PG8_WAIT_V(6); PG8_BAR;
    } else {
        PG8_STAGE(PG8_SB(0, 0), cB, voffB); PG8_STAGE(PG8_SA(0, 0), cA, voffA); PG8_STAGE(PG8_SB(0, 1), cB + hstep, voffB); PG8_STAGE(PG8_SA(0, 1), cA + hstep, voffA);
        if (wr == 1) PG8_BAR;
        PG8_WAIT_V(4); PG8_BAR;
        PG8_STAGE(PG8_SB(1, 0), cB + kstep, voffB); PG8_STAGE(PG8_SA(1, 0), cA + kstep, voffA); PG8_STAGE(PG8_SB(1, 1), cB + hstep + kstep, voffB);
        PG8_WAIT_V(6); PG8_BAR;
    }
    for (;;) {
        const bool has_next = S.next(ui + 1, nxt);
        const char* nA = has_next ? (const char*)g.A + (size_t)nxt.pm * tstep + (size_t)nxt.koff * 2 : cA; const char* nB = has_next ? (const char*)g.Bt + (size_t)nxt.pn * tstep + (size_t)nxt.e * g.estride + (size_t)nxt.koff * 2 : cB;
        for (int t = 0; t < nt; t += 2) {
            const bool last = (t == nt - 2);
            const char* a1 = cA + (size_t)(t + 1) * kstep;
            const char* a2 = last ? nA : cA + (size_t)(t + 2) * kstep; const char* b2 = last ? nB : cB + (size_t)(t + 2) * kstep;
            const char* a3 = a2 + kstep; const char* b3 = b2 + kstep;
            if (last && has_next) S.a_ready(nxt);
            if constexpr (SP2) {
            PG8_LDB(B0, 0, 0); PG8_LDB(B1, 0, 1); PG8_SCHED; PG8_LDA(At, 0, 0); PG8_STAGE(PG8_SA(1, 1), a1 + hstep, voffA);
            PG8_WAIT_V(8); PG8_WAIT_L(0); PG8_BAR; PG8_MMA(0, 0, At, B0); PG8_MMA(0, 1, At, B1); PG8_BAR; PG8_SCHED;
            PG8_LDA(At, 0, 1); PG8_STAGE(PG8_SB(0, 0), b2, voffB); PG8_STAGE(PG8_SB(0, 1), b2 + hstep, voffB); PG8_STAGE(PG8_SA(0, 0), a2, voffA);
            PG8_WAIT_V(8); PG8_WAIT_L(0); PG8_BAR; PG8_MMA(1, 0, At, B0); PG8_MMA(1, 1, At, B1); PG8_BAR; PG8_SCHED;
            PG8_LDB(B0, 1, 0); PG8_LDB(B1, 1, 1); PG8_SCHED; PG8_LDA(At, 1, 0); PG8_STAGE(PG8_SA(0, 1), a2 + hstep, voffA);
            PG8_WAIT_V(8); PG8_WAIT_L(0); PG8_BAR; PG8_MMA(0, 0, At, B0); PG8_MMA(0, 1, At, B1); PG8_BAR; PG8_SCHED;
            PG8_LDA(At, 1, 1); PG8_STAGE(PG8_SB(1, 0), b3, voffB); PG8_STAGE(PG8_SB(1, 1), b3 + hstep, voffB); PG8_STAGE(PG8_SA(1, 0), a3, voffA);
            PG8_WAIT_V(8); PG8_WAIT_L(0); PG8_BAR; PG8_MMA(1, 0, At, B0); PG8_MMA(1, 1, At, B1); PG8_BAR; PG8_SCHED;
            } else {
            PG8_LDB(B0, 0, 0); PG8_SCHED; PG8_LDA(At, 0, 0); PG8_STAGE(PG8_SA(1, 1), a1 + hstep, voffA);
            PG8_WAIT_L(8); PG8_BAR; PG8_WAIT_L(0); PG8_MMA(0, 0, At, B0); PG8_BAR; PG8_SCHED;
            PG8_LDB(B1, 0, 1); PG8_STAGE(PG8_SB(0, 0), b2, voffB);
            PG8_BAR; PG8_WAIT_L(0); PG8_MMA(0, 1, At, B1); PG8_BAR;
            PG8_LDA(At, 0, 1); PG8_STAGE(PG8_SA(0, 0), a2, voffA);
            PG8_BAR; PG8_WAIT_L(0); PG8_MMA(1, 0, At, B0); PG8_BAR; PG8_SCHED;
            PG8_STAGE(PG8_SB(0, 1), b2 + hstep, voffB);
            PG8_WAIT_V(6); PG8_BAR; PG8_MMA(1, 1, At, B1); PG8_BAR;
            PG8_LDB(B0, 1, 0); PG8_SCHED; PG8_LDA(At, 1, 0); PG8_STAGE(PG8_SA(0, 1), a2 + hstep, voffA);
            PG8_WAIT_L(8); PG8_BAR; PG8_WAIT_L(0); PG8_MMA(0, 0, At, B0); PG8_BAR; PG8_SCHED;
            PG8_LDB(B1, 1, 1); PG8_STAGE(PG8_SB(1, 0), b3, voffB);
            PG8_BAR; PG8_WAIT_L(0); PG8_MMA(0, 1, At, B1); PG8_BAR;
            PG8_LDA(At, 1, 1); PG8_STAGE(PG8_SA(1, 0), a3, voffA);
            PG8_BAR; PG8_WAIT_L(0); PG8_MMA(1, 0, At, B0); PG8_BAR; PG8_SCHED;
            PG8_STAGE(PG8_SB(1, 1), b3 + hstep, voffB);
            PG8_WAIT_V(6); PG8_BAR; PG8_MMA(1, 1, At, B1); PG8_BAR;
            }
        }
        if constexpr (ALIGN_EPI) { if (wr == 0) PG8_BAR; }
        if constexpr (!Epi::AFTER_DRAIN) { E(acc, cur, wr, wc, fr, fq); S.done(cur); }
        if (!has_next) break;
#pragma unroll
        for (int a = 0; a < 2; ++a)
#pragma unroll
            for (int b = 0; b < 2; ++b)
#pragma unroll
                for (int m = 0; m < 4; ++m)
#pragma unroll
                    for (int n = 0; n < 2; ++n) acc[a][b][m][n] = (f32x4){0.f, 0.f, 0.f, 0.f};
        cur = nxt; cA = nA; cB = nB; ++ui;
        if constexpr (ALIGN_EPI) { if (wr == 1) PG8_BAR; }
    }
    PG8_WAIT_V(0);
    if constexpr (!ALIGN_EPI) { if (wr == 0) PG8_BAR; }
    PG8_BAR;
    if constexpr (Epi::AFTER_DRAIN) { E.fused(acc, cur, wr, wc, fr, fq, lds, wid, lane); S.done(cur); }
#undef PG8_SA
#undef PG8_SB
#undef PG8_STAGE
#undef PG8_LDA
#undef PG8_LDB
#undef PG8_MMA
#undef PG8_WAIT_V
#undef PG8_WAIT_L
#undef PG8_BAR
#undef PG8_SCHED
}
}

#ifndef MK_PER_PHASE
#define MK_PER_PHASE 0
#endif
typedef unsigned short bf16;
typedef float f32x4 __attribute__((ext_vector_type(4)));
typedef float f32x16 __attribute__((ext_vector_type(16)));
typedef short bf16x8 __attribute__((ext_vector_type(8)));
typedef unsigned u32x4 __attribute__((ext_vector_type(4)));
typedef unsigned u32x2 __attribute__((ext_vector_type(2)));

constexpr int NB = 4, SEQ = 4096, DM = 1024, M = NB * SEQ;
constexpr int NPROJ = 3584, PLD = 3328;
constexpr int C_QN = 0, C_KV = 512, C_QKM = 1280, C_VM = 2304, C_OM = 2816;
constexpr int IN_COLS = 3360;
constexpr int DFF = 2816, DFFE = 3584, NE = 8, MAXR = 34816;
constexpr int NWAVES = 8, NTHR = 512;
constexpr float EPSN = 1e-6f;
constexpr float LOG2E = 1.4426950408889634f;

constexpr size_t MiB = 1u << 20;
constexpr size_t WS_CTL = 0, CTL_ZERO_BYTES = 64 * 1024;
constexpr size_t WS_MODP = 1 * MiB;
constexpr size_t WS_C1P = WS_MODP + 1572864;
constexpr size_t WS_BIASP = WS_C1P + 32768;
constexpr size_t WS_TOPI = 3 * MiB;
constexpr size_t WS_TOPW = WS_TOPI + 131072;
constexpr size_t WS_DEST = WS_TOPW + 131072;
constexpr size_t WS_RWT = WS_DEST + 131072 + 65536;
constexpr size_t WS_MODF = WS_DEST + 131072 + 65536 + 32768;
constexpr size_t WS_WCNT = WS_DEST + 131072;
constexpr size_t WS_MOE_GU = 4 * MiB;
constexpr size_t WS_YG = WS_MOE_GU;
constexpr size_t WS_XG = 116 * MiB;
constexpr size_t WS_ARENA = 184 * MiB;
constexpr size_t WS_HG = WS_ARENA;
constexpr size_t WS_XN = WS_ARENA;
constexpr size_t WS_PROJ = WS_ARENA + 32 * MiB;
constexpr size_t WS_HB = WS_PROJ;
constexpr size_t WS_GATES = WS_ARENA + 136 * MiB;
constexpr size_t WS_KC = WS_ARENA + 138 * MiB;
constexpr size_t WS_NL = WS_KC + 524288;
constexpr size_t WS_SC = WS_ARENA + 139 * MiB;
constexpr size_t WS_MP = WS_SC + 65536;
constexpr size_t WS_LC = WS_ARENA + 140 * MiB;
constexpr size_t WS_CP = WS_ARENA + 204 * MiB;
constexpr size_t WS_NP = WS_ARENA + 236 * MiB;
constexpr size_t WS_Y = WS_ARENA + 237 * MiB;
constexpr size_t WS_WSMALL = WS_ARENA + 269 * MiB;
constexpr size_t WS_WIN = WS_WSMALL;
constexpr size_t WS_WOUT = WS_WIN + 14 * MiB;
constexpr size_t WS_WGU = WS_WOUT + 4 * MiB;
constexpr size_t WS_WDN = WS_WGU + 11 * MiB;
constexpr size_t WS_W1T = WS_WDN + 5767168;
constexpr size_t WS_END = WS_W1T + 2 * MiB;
constexpr size_t WS_MOE_DN = WS_HG + (size_t)MAXR * DFFE * 2;
static_assert(WS_MOE_DN + (size_t)NE * DM * DFFE * 2 <= WS_END, "MOE_DN fits");
static_assert(WS_YG + (size_t)MAXR * DM * 4 <= WS_ARENA, "YG fits");
static_assert(WS_XG + (size_t)MAXR * DM * 2 <= WS_ARENA, "XG fits");
constexpr int CW_CNT = 0, CW_CUR = 64, CW_BAR = 1024;
constexpr int LDS_BAR_ST = 131072;

constexpr int LDS_BYTES = 147456;

struct Params { const float* in[23]; float* out; unsigned char* ws; int ph_lo, ph_hi, li, pad; };

__device__ __forceinline__ float bf2f(unsigned v) { return __uint_as_float(v << 16); }
__device__ __forceinline__ unsigned f2bf(float f) { unsigned u = __float_as_uint(f); return (u + 0x7fffu + ((u >> 16) & 1u)) >> 16; }
typedef float f32x2_t __attribute__((ext_vector_type(2))); typedef __bf16 bf16x2_t __attribute__((ext_vector_type(2)));
__device__ __forceinline__ unsigned pk2(float lo, float hi) { f32x2_t v = {lo, hi}; bf16x2_t b = __builtin_convertvector(v, bf16x2_t); return __builtin_bit_cast(unsigned, b); }
__device__ __forceinline__ float wave_sum(float v) {
#pragma unroll
    for (int o = 1; o < 64; o <<= 1) v += __shfl_xor(v, o);
    return v;
}
__device__ __forceinline__ float wave_max(float v) {
#pragma unroll
    for (int o = 1; o < 64; o <<= 1) v = fmaxf(v, __shfl_xor(v, o));
    return v;
}
__device__ __forceinline__ float sigmoidf_(float x) { return 1.0f / (1.0f + __expf(-x)); }
__device__ __forceinline__ float siluf_(float x) { return x / (1.0f + __expf(-x)); }
__device__ __forceinline__ float logsigmoidf_(float x) { return fminf(x, 0.f) - log1pf(__expf(-fabsf(x))); }
#define LDS_WAIT() asm volatile("s_waitcnt lgkmcnt(0)" ::: "memory")

__device__ __forceinline__ f32x4 ldu4(const float* ubase, unsigned voffb) { return *(const f32x4*)((const char*)ubase + voffb); }
__device__ __forceinline__ f32x4 mod4u(const float* ada_b, const float* MODP, int l, int b, int ucol, unsigned voffb) {
    f32x4 v = ldu4(ada_b + l * 6144 + ucol, voffb);
#pragma unroll
    for (int kc = 0; kc < 8; ++kc) v += ldu4(MODP + (size_t)((l * 8 + kc) * 4 + b) * 6144 + ucol, voffb);
    return v;
}
__device__ __forceinline__ f32x4 mod4(const float* ada_b, const float* MODP, int l, int b, int col) {
    f32x4 v = *(const f32x4*)(ada_b + l * 6144 + col);
#pragma unroll
    for (int kc = 0; kc < 8; ++kc) v += *(const f32x4*)(MODP + (size_t)((l * 8 + kc) * 4 + b) * 6144 + col);
    return v;
}

struct EpiProj {
    static constexpr bool PERM = false, AFTER_DRAIN = false;
    bf16* PROJ; float* GATES; const float* bias;
    __device__ __forceinline__ void operator()(const f32x4 (&acc)[2][2][4][2], const pg8::Unit& u, int wr, int wc, int fr, int fq) const {
        const int row0 = u.pm * 256 + wr * 64 + fr, col0 = u.pn * 256 + wc * 32 + 4 * fq;
        f32x4 bv[2][2];
#pragma unroll
        for (int bj = 0; bj < 2; ++bj)
#pragma unroll
            for (int n = 0; n < 2; ++n) bv[bj][n] = *(const f32x4*)(bias + col0 + bj * 128 + n * 16);
        if (u.pn < 13) {
#pragma unroll
            for (int ai = 0; ai < 2; ++ai)
#pragma unroll
                for (int m = 0; m < 4; ++m) { bf16* rowp = PROJ + (size_t)(row0 + ai * 128 + m * 16) * PLD + col0;
#pragma unroll
                    for (int bj = 0; bj < 2; ++bj)
#pragma unroll
                        for (int n = 0; n < 2; ++n) { const f32x4 v = acc[ai][bj][m][n] + bv[bj][n]; u32x2 w; w.x = pk2(v[0], v[1]); w.y = pk2(v[2], v[3]); *(u32x2*)(rowp + bj * 128 + n * 16) = w; } }
        } else if (wc == 0) {
#pragma unroll
            for (int ai = 0; ai < 2; ++ai)
#pragma unroll
                for (int m = 0; m < 4; ++m) { float* rowp = GATES + (size_t)(row0 + ai * 128 + m * 16) * 32 + 4 * fq;
#pragma unroll
                    for (int n = 0; n < 2; ++n) *(f32x4*)(rowp + n * 16) = acc[ai][0][m][n] + bv[0][n]; }
        }
    }
};
struct EpiRes {
    static constexpr bool PERM = false, AFTER_DRAIN = false;
    const float* xin; float* xout; const float* MODF; int l, goff;
    __device__ __forceinline__ void operator()(const f32x4 (&acc)[2][2][4][2], const pg8::Unit& u, int wr, int wc, int fr, int fq) const {
        const int row0 = u.pm * 256 + wr * 64 + fr, col0 = u.pn * 256 + wc * 32 + 4 * fq, b = (u.pm * 256) >> 12;
        f32x4 gv[2][2];
#pragma unroll
        for (int bj = 0; bj < 2; ++bj)
#pragma unroll
            for (int n = 0; n < 2; ++n) gv[bj][n] = *(const f32x4*)(MODF + (size_t)(l * 4 + b) * 6144 + goff + col0 + bj * 128 + n * 16);
#pragma unroll
        for (int ai = 0; ai < 2; ++ai)
#pragma unroll
            for (int m = 0; m < 4; ++m) { const size_t off = (size_t)(row0 + ai * 128 + m * 16) * DM + col0;
#pragma unroll
                for (int bj = 0; bj < 2; ++bj)
#pragma unroll
                    for (int n = 0; n < 2; ++n) { const f32x4 x = *(const f32x4*)(xin + off + bj * 128 + n * 16); *(f32x4*)(xout + off + bj * 128 + n * 16) = x + gv[bj][n] * acc[ai][bj][m][n]; } }
    }
};
struct EpiSwiglu {
    static constexpr bool PERM = false, AFTER_DRAIN = false;
    bf16* H; int ldh;
    __device__ __forceinline__ void operator()(const f32x4 (&acc)[2][2][4][2], const pg8::Unit& u, int wr, int wc, int fr, int fq) const {
        const int row0 = u.pm * 256 + wr * 64 + fr, hc0 = u.pn * 128 + wc * 32 + 4 * fq;
#pragma unroll
        for (int ai = 0; ai < 2; ++ai)
#pragma unroll
            for (int m = 0; m < 4; ++m) { bf16* rowp = H + (size_t)(row0 + ai * 128 + m * 16) * ldh + hc0;
#pragma unroll
                for (int n = 0; n < 2; ++n) { const f32x4 g = acc[ai][0][m][n], uu = acc[ai][1][m][n]; f32x4 v;
#pragma unroll
                    for (int k = 0; k < 4; ++k) v[k] = siluf_(g[k]) * uu[k];
                    u32x2 w; w.x = pk2(v[0], v[1]); w.y = pk2(v[2], v[3]); *(u32x2*)(rowp + n * 16) = w; } }
    }
};
struct EpiF32 {
    static constexpr bool PERM = false, AFTER_DRAIN = false;
    float* O;
    __device__ __forceinline__ void operator()(const f32x4 (&acc)[2][2][4][2], const pg8::Unit& u, int wr, int wc, int fr, int fq) const {
        const int row0 = u.pm * 256 + wr * 64 + fr, col0 = u.pn * 256 + wc * 32 + 4 * fq;
#pragma unroll
        for (int ai = 0; ai < 2; ++ai)
#pragma unroll
            for (int m = 0; m < 4; ++m) { const size_t off = (size_t)(row0 + ai * 128 + m * 16) * DM + col0;
#pragma unroll
                for (int bj = 0; bj < 2; ++bj)
#pragma unroll
                    for (int n = 0; n < 2; ++n) *(f32x4*)(O + off + bj * 128 + n * 16) = acc[ai][bj][m][n]; }
    }
};
template <int SPLIT> struct MoeOrderT {
    int cum[9]; int nN, G, c, lo, hi, kpart;
    __device__ __forceinline__ void init(const unsigned* cnt, int nN_, int G_, int c_) { nN = nN_; G = G_; c = c_; cum[0] = 0; kpart = 0;
#pragma unroll
        for (int e = 0; e < 8; ++e) cum[e + 1] = cum[e] + (int)((cnt[e] + 255u) >> 8);
        lo = 0; hi = cum[8] * nN; }
    __device__ __forceinline__ int total() const { return cum[8] * nN; }
    __device__ __forceinline__ bool next(int i, pg8::Unit& u) const {
        const int q = i * G + c; if (q >= (hi - lo) * SPLIT) return false;
        const int L = lo + q / SPLIT, ks = q % SPLIT;
        int se = 0, sb = 0, st = 1;
#pragma unroll
        for (int e = 0; e < 8; ++e) { if (L >= cum[e] * nN && L < cum[e + 1] * nN) { se = e; sb = cum[e]; st = cum[e + 1] - cum[e]; } }
        const int local = L - sb * nN; u.pm = sb + local % st; u.pn = local / st; u.e = se; u.koff = ks * kpart; u.aux = q; return true;
    }
    __device__ __forceinline__ void a_ready(const pg8::Unit&) const {}
    __device__ __forceinline__ void done(const pg8::Unit&) const {}
};
typedef MoeOrderT<1> MoeOrder;
struct EpiPart {
    static constexpr bool PERM = false, AFTER_DRAIN = false;
    float* PART;
    __device__ __forceinline__ void operator()(const f32x4 (&acc)[2][2][4][2], const pg8::Unit& u, int wr, int wc, int fr, int fq) const {
        float* base = PART + (size_t)u.aux * 65536 + (size_t)(wr * 64 + fr) * 256 + wc * 32 + 4 * fq;
#pragma unroll
        for (int ai = 0; ai < 2; ++ai)
#pragma unroll
            for (int m = 0; m < 4; ++m)
#pragma unroll
                for (int bj = 0; bj < 2; ++bj)
#pragma unroll
                    for (int n = 0; n < 2; ++n) *(f32x4*)(base + (size_t)(ai * 128 + m * 16) * 256 + bj * 128 + n * 16) = acc[ai][bj][m][n];
    }
};
constexpr size_t WS_PART = 140 * MiB;
static_assert(WS_YG + (size_t)MAXR * DM * 4 <= WS_PART && WS_PART + (size_t)128 * 65536 * 4 <= WS_ARENA, "PART fits");

__device__ __forceinline__ void conv_item64(const float* W, int ldw, int scol, int k0, bf16* dst, int dpitch, bf16* scr, int lane) {
    const int kq = lane >> 4, n4 = lane & 15;
    f32x4 v[16];
    const float* src = W + (size_t)(k0 + kq) * ldw + (scol >= 0 ? scol : 0);
#pragma unroll
    for (int i = 0; i < 16; ++i) v[i] = *(const f32x4*)(src + (size_t)(4 * i) * ldw);
    if (scol < 0) {
#pragma unroll
        for (int i = 0; i < 16; ++i) v[i] = (f32x4){0.f, 0.f, 0.f, 0.f}; }
#pragma unroll
    for (int i = 0; i < 16; ++i) { const int k = 4 * i + kq; const unsigned p0 = pk2(v[i][0], v[i][1]), p1 = pk2(v[i][2], v[i][3]); bf16* d = scr + (4 * n4) * 72 + k;
        d[0] = (bf16)(p0 & 0xffffu); d[72] = (bf16)(p0 >> 16); d[144] = (bf16)(p1 & 0xffffu); d[216] = (bf16)(p1 >> 16); }
    LDS_WAIT();
    const int c = lane & 7;
#pragma unroll
    for (int j = 0; j < 8; ++j) { const int n = (lane >> 3) + 8 * j; const u32x4 o = *(const u32x4*)(scr + n * 72 + 8 * c); *(u32x4*)(dst + (size_t)n * dpitch + 8 * c) = o; }
    LDS_WAIT();
}
__device__ __forceinline__ int proj_src_col(int n) { return n < 1280 ? n : (n < 3328 ? n + 24 : (n < 3352 ? n - 2048 : (n < 3360 ? n : -1))); }

struct CItem { const float* src; bf16* dst; int ldw, dpitch, zero; };
__device__ __forceinline__ void conv_issue(const CItem& it, f32x4 (&v)[16]) {
#pragma unroll
    for (int i = 0; i < 16; ++i) v[i] = *(const f32x4*)(it.src + (size_t)(4 * i) * it.ldw);
}
__device__ __forceinline__ void conv_zero(f32x4 (&v)[16]) {
#pragma unroll
    for (int i = 0; i < 16; ++i) v[i] = (f32x4){0.f, 0.f, 0.f, 0.f};
}
__device__ __forceinline__ void conv_finish(const CItem& it, f32x4 (&v)[16], bf16* scr, int lane) {
    const int kq = lane >> 4, n4 = lane & 15;
    if (it.zero) {
#pragma unroll
        for (int i = 0; i < 16; ++i) v[i] = (f32x4){0.f, 0.f, 0.f, 0.f}; }
#pragma unroll
    for (int i = 0; i < 16; ++i) { const int k = 4 * i + kq; const unsigned p0 = pk2(v[i][0], v[i][1]), p1 = pk2(v[i][2], v[i][3]); bf16* d = scr + (4 * n4) * 72 + k;
        d[0] = (bf16)(p0 & 0xffffu); d[72] = (bf16)(p0 >> 16); d[144] = (bf16)(p1 & 0xffffu); d[216] = (bf16)(p1 >> 16); }
    LDS_WAIT();
    const int c = lane & 7;
#pragma unroll
    for (int j = 0; j < 8; ++j) { const int n = (lane >> 3) + 8 * j; const u32x4 o = *(const u32x4*)(scr + n * 72 + 8 * c); *(u32x4*)(it.dst + (size_t)n * it.dpitch + 8 * c) = o; }
    LDS_WAIT();
}
__device__ __forceinline__ void citem_make(CItem& it, const float* W, int ldw, int scol, int k0, bf16* dst, int dpitch, int lane) {
    it.src = W + (size_t)(k0 + (lane >> 4)) * ldw + (scol >= 0 ? scol : 0); it.dst = dst; it.ldw = ldw; it.dpitch = dpitch; it.zero = scol < 0;
}
constexpr int MGU_P = 6592;
constexpr int D_WOUT0 = 256, D_WGU = 1408, D_WDN = 704, D_WOUT1 = 256, D_WIN1 = 896, D_W1T1 = 128, D_TOTAL = D_WOUT0 + D_WGU + D_WDN + D_WOUT1 + D_WIN1 + D_W1T1 + MGU_P;
__device__ __forceinline__ bool ditem_decode(const Params& P, int d, int lane, CItem& it) {
    if (d < 0 || d >= D_TOTAL) return false;
    unsigned char* ws = P.ws; const int n4 = 4 * (lane & 15); int r = d;
    if (r < D_WOUT0) { const int kb = r / 16, nb = r % 16; citem_make(it, P.in[14], DM, nb * 64 + n4, kb * 64, (bf16*)(ws + WS_WOUT) + (size_t)(nb * 64) * DM + kb * 64, DM, lane); return true; }
    r -= D_WOUT0;
    if (r < D_WGU) { const int kb = r / 88, nb = r % 88, n0 = nb * 64, t = n0 >> 8, w = n0 & 255; const float* src = (w < 128) ? P.in[15] : P.in[16];
        citem_make(it, src, DFF, t * 128 + (w & 127) + n4, kb * 64, (bf16*)(ws + WS_WGU) + (size_t)n0 * DM + kb * 64, DM, lane); return true; }
    r -= D_WGU;
    if (r < D_WDN) { const int kb = r / 16, nb = r % 16; citem_make(it, P.in[17], DM, nb * 64 + n4, kb * 64, (bf16*)(ws + WS_WDN) + (size_t)(nb * 64) * DFF + kb * 64, DFF, lane); return true; }
    r -= D_WDN;
    if (r < D_WOUT1) { const int kb = r / 16, nb = r % 16; citem_make(it, P.in[14] + (size_t)DM * DM, DM, nb * 64 + n4, kb * 64, (bf16*)(ws + WS_WOUT) + ((size_t)DM + nb * 64) * DM + kb * 64, DM, lane); return true; }
    r -= D_WOUT1;
    if (r < D_WIN1) { const int kb = r / 56, nb = r % 56; citem_make(it, P.in[6] + (size_t)DM * IN_COLS, IN_COLS, proj_src_col(nb * 64 + n4), kb * 64, (bf16*)(ws + WS_WIN) + ((size_t)NPROJ + nb * 64) * DM + kb * 64, DM, lane); return true; }
    r -= D_WIN1;
    if (r < D_W1T1) { const int lj = 2 + r / 64, q = r % 64, kb = q / 2, nb = q % 2; citem_make(it, P.in[9] + (size_t)lj * 2048 * 128, 128, nb * 64 + n4, kb * 64, (bf16*)(ws + WS_W1T) + ((size_t)lj * 128 + nb * 64) * 2048 + kb * 64, 2048, lane); return true; }
    r -= D_W1T1;
    { const int e = r / 1792, q = r % 1792, kb = q / 112, nb = q % 112, n0 = nb * 64, t = n0 >> 8, w = n0 & 255; const float* src = ((w < 128) ? P.in[19] : P.in[20]) + (size_t)e * DM * DFFE;
        citem_make(it, src, DFFE, t * 128 + (w & 127) + n4, kb * 64, (bf16*)(ws + WS_MOE_GU) + ((size_t)e * 7168 + n0) * DM + kb * 64, DM, lane); return true; }
}
constexpr int LDS_DCONV = 57344;

__device__ __forceinline__ void conv_moe_dn_items(const Params& P, bf16* scr, int gw, int NGW, int lane) {
    bf16* dstb = (bf16*)(P.ws + WS_MOE_DN);
    constexpr int NBLK = 16, KBLK = 56, PER_E = NBLK * KBLK;
    for (int it = gw; it < NE * PER_E; it += NGW) { const int e = it / PER_E, r = it % PER_E, kb = r / NBLK, nb = r % NBLK;
        conv_item64(P.in[21] + (size_t)e * DFFE * DM, DM, nb * 64 + 4 * (lane & 15), kb * 64, dstb + ((size_t)e * DM + nb * 64) * DFFE + kb * 64, DFFE, scr, lane); }
}

__device__ __forceinline__ void prologue(const Params& P, unsigned char* lds, int gw, int NGW, int wave, int lane) {
    bf16* scr = (bf16*)(lds + wave * 16384);
    unsigned char* ws = P.ws;
    constexpr int I_WIN = 56 * 16, I_W1T = 2 * 2 * 32;
    constexpr int I_MOD = 2 * 24 * 8, I_C1 = 2 * 2 * 16 * 2, I_BIAS = 112 + 16;
    constexpr int NIT = I_WIN + I_W1T + I_MOD + I_C1 + I_BIAS;
    const int n4 = 4 * (lane & 15);
    for (int it = gw; it < NIT; it += NGW) {
        int r = it;
        if (r < I_MOD) {
            const int l = r / 192, cb = (r % 192) / 8, kc = r % 8, col = cb * 256 + 4 * lane;
            const float* aw = P.in[2] + (size_t)l * DM * 6144; const float* c = P.in[1];
            f32x4 a0 = {0, 0, 0, 0}, a1 = a0, a2 = a0, a3 = a0;
#pragma unroll 8
            for (int k = kc * 128; k < kc * 128 + 128; ++k) { const f32x4 w = *(const f32x4*)(aw + (size_t)k * 6144 + col);
                a0 += siluf_(c[k]) * w; a1 += siluf_(c[DM + k]) * w; a2 += siluf_(c[2 * DM + k]) * w; a3 += siluf_(c[3 * DM + k]) * w; }
            float* o = (float*)(ws + WS_MODP) + (size_t)((l * 8 + kc) * 4) * 6144 + col;
            *(f32x4*)(o) = a0; *(f32x4*)(o + 6144) = a1; *(f32x4*)(o + 2 * 6144) = a2; *(f32x4*)(o + 3 * 6144) = a3;
            continue; }
        r -= I_MOD;
        if (r < I_C1) {
            const int lj = r / 32, kc = (r % 32) / 2, hh = r % 2, hid = hh * 64 + lane;
            const float* pe = P.in[8] + (size_t)lj * 2048; const float* w1 = P.in[9] + (size_t)lj * 2048 * 128;
            float a = 0.f;
#pragma unroll 8
            for (int k = kc * 128; k < kc * 128 + 128; ++k) a += pe[k] * w1[(size_t)k * 128 + hid];
            ((float*)(ws + WS_C1P))[(lj * 16 + kc) * 128 + hid] = a;
            continue; }
        r -= I_C1;
        if (r < I_BIAS) {
            if (r >= 112) { const int col = (r - 112) * 64 + lane; const float* rw = P.in[18] + (size_t)col * 8; float* o = (float*)(ws + WS_RWT) + col;
#pragma unroll
                for (int e = 0; e < 8; ++e) o[e * 1024] = rw[e];
                continue; }
            const int l = r / 56, n = (r % 56) * 64 + lane, s = proj_src_col(n);
            ((float*)(ws + WS_BIASP))[l * NPROJ + n] = s >= 0 ? P.in[7][l * IN_COLS + s] : 0.f;
            continue; }
        r -= I_BIAS;
        if (r < I_WIN) { const int kb = r / 56, nb = r % 56;
            conv_item64(P.in[6], IN_COLS, proj_src_col(nb * 64 + n4), kb * 64, (bf16*)(ws + WS_WIN) + (size_t)(nb * 64) * DM + kb * 64, DM, scr, lane); continue; }
        r -= I_WIN;
        { const int lj = r / 64, q = r % 64, kb = q / 2, nb = q % 2;
            conv_item64(P.in[9] + (size_t)lj * 2048 * 128, 128, nb * 64 + n4, kb * 64, (bf16*)(ws + WS_W1T) + ((size_t)lj * 128 + nb * 64) * 2048 + kb * 64, 2048, scr, lane); }
    }
}
constexpr int MGU_ITEMS = 8 * 112 * 16;
__device__ __forceinline__ void conv_moe_gu_items(const Params& P, bf16* scr, int lo, int hi, int widx, int nw, int lane) {
    const int n4 = 4 * (lane & 15);
    for (int r = lo + widx; r < hi; r += nw) { const int e = r / 1792, q = r % 1792, kb = q / 112, nb = q % 112, n0 = nb * 64, t = n0 >> 8, w = n0 & 255;
        const float* src = ((w < 128) ? P.in[19] : P.in[20]) + (size_t)e * DM * DFFE; const int sc0 = t * 128 + (w & 127);
        conv_item64(src, DFFE, sc0 + n4, kb * 64, (bf16*)(P.ws + WS_MOE_GU) + ((size_t)e * 7168 + n0) * DM + kb * 64, DM, scr, lane); }
}

template <int HF> __device__ __forceinline__ void bfly_reduce(float (&pv)[16], int lane) {
    const bool up = (lane & HF) != 0;
#pragma unroll
    for (int i = 0; i < HF; ++i) { const float keep = up ? pv[i + HF] : pv[i], send = up ? pv[i] : pv[i + HF]; pv[i] = keep + __shfl_xor(send, HF); }
    if constexpr (HF > 1) bfly_reduce<HF / 2>(pv, lane);
}
__device__ __forceinline__ void stage_mod2(const float* ada_b, const float* MODP, int l, int b, int offA, int offB, float* dstA, float* dstB, int tid) {
    const int which = tid >> 8, c4 = (tid & 255) * 4, off = (which ? offB : offA) + c4;
    f32x4 p[9]; p[0] = *(const f32x4*)(ada_b + l * 6144 + off);
#pragma unroll
    for (int kc = 0; kc < 8; ++kc) p[kc + 1] = *(const f32x4*)(MODP + (size_t)((l * 8 + kc) * 4 + b) * 6144 + off);
    f32x4 v = p[0];
#pragma unroll
    for (int kc = 0; kc < 8; ++kc) v += p[kc + 1];
    *(f32x4*)((which ? dstB : dstA) + c4) = v;
}
__device__ __forceinline__ void mod_finalize(const Params& P, int l, int bx, int tid) {
    const int idx = bx * NTHR + tid; if (idx >= 6144) return;
    const int b = idx / 1536, c4 = (idx % 1536) * 4; const float* MODP = (const float*)(P.ws + WS_MODP);
    f32x4 p[9]; p[0] = *(const f32x4*)(P.in[3] + l * 6144 + c4);
#pragma unroll
    for (int kc = 0; kc < 8; ++kc) p[kc + 1] = *(const f32x4*)(MODP + (size_t)((l * 8 + kc) * 4 + b) * 6144 + c4);
    f32x4 v = p[0];
#pragma unroll
    for (int kc = 0; kc < 8; ++kc) v += p[kc + 1];
    *(f32x4*)((float*)(P.ws + WS_MODF) + (size_t)(l * 4 + b) * 6144 + c4) = v;
}
template <bool ROUTER>
__device__ __forceinline__ void rowpass(const Params& P, unsigned char* lds, const float* X, const float* gain, int l, int sh_off, int sc_off, int bx, int G, int tid, int wave, int lane) {
    const float* ada_b = P.in[3]; const float* MODP = (const float*)(P.ws + WS_MODP);
    bf16* XN = (bf16*)(P.ws + WS_XN);
    float* mA = (float*)lds; float* mB = mA + 1024;
    for (int wi0 = bx * NWAVES; wi0 < M / 8; wi0 += G * NWAVES) {
        const int wi = wi0 + wave, row0 = wi * 8, b = (wi0 * 8) >> 12;
        __syncthreads();
        stage_mod2(ada_b, MODP, l, b, sc_off, sh_off, mA, mB, tid);
        __syncthreads();
        f32x4 sg[4], sh[4]; const unsigned lob = 16u * (unsigned)lane;
#pragma unroll
        for (int j = 0; j < 4; ++j) { const f32x4 g = ldu4(gain + 256 * j, lob); sg[j] = (*(const f32x4*)(mA + 4 * lane + 256 * j) + 1.0f) * g; sh[j] = *(const f32x4*)(mB + 4 * lane + 256 * j); }
        unsigned hcnt = 0u;
        f32x4 nx[2][4];
#pragma unroll
        for (int r = 0; r < 2; ++r)
#pragma unroll
            for (int j = 0; j < 4; ++j) nx[r][j] = ldu4(X + (size_t)(row0 + r) * DM + 256 * j, lob);
#pragma unroll 1
        for (int grp = 0; grp < 4; ++grp) {
            f32x4 hrow[2][4];
#pragma unroll
            for (int r = 0; r < 2; ++r)
#pragma unroll
                for (int j = 0; j < 4; ++j) hrow[r][j] = nx[r][j];
            if (grp < 3) {
#pragma unroll
                for (int r = 0; r < 2; ++r)
#pragma unroll
                    for (int j = 0; j < 4; ++j) nx[r][j] = ldu4(X + (size_t)(row0 + 2 * grp + 2 + r) * DM + 256 * j, lob); }
#pragma unroll
            for (int r = 0; r < 2; ++r) {
                const int row = row0 + 2 * grp + r;
                float ss = 0.f;
#pragma unroll
                for (int j = 0; j < 4; ++j) { const f32x4 v = hrow[r][j]; ss += (v[0] * v[0] + v[1] * v[1]) + (v[2] * v[2] + v[3] * v[3]); }
                const float rs = rsqrtf(wave_sum(ss) * (1.0f / DM) + EPSN);
#pragma unroll
                for (int j = 0; j < 4; ++j) { const f32x4 v = hrow[r][j] * rs * sg[j] + sh[j]; u32x2 w; w.x = pk2(v[0], v[1]); w.y = pk2(v[2], v[3]);
                    *(u32x2*)((char*)(XN + (size_t)row * DM + 256 * j) + (lob >> 1)) = w; hrow[r][j] = v; }
            }
            if constexpr (ROUTER) {
                const float* rwt = (const float*)(P.ws + WS_RWT);
                float pv[16];
#pragma unroll
                for (int e = 0; e < 8; ++e) { f32x4 w[4];
#pragma unroll
                    for (int j = 0; j < 4; ++j) w[j] = ldu4(rwt + e * 1024 + 256 * j, lob);
#pragma unroll
                    for (int r = 0; r < 2; ++r) { float a = 0.f;
#pragma unroll
                        for (int j = 0; j < 4; ++j) a += (hrow[r][j][0] * w[j][0] + hrow[r][j][1] * w[j][1]) + (hrow[r][j][2] * w[j][2] + hrow[r][j][3] * w[j][3]);
                        pv[r * 8 + e] = a; } }
                bfly_reduce<8>(pv, lane);
                float lg = pv[0]; lg += __shfl_xor(lg, 16); lg += __shfl_xor(lg, 32);
                const int e = lane & 7;
                float v1 = lg; int i1 = e;
#pragma unroll
                for (int of = 1; of < 8; of <<= 1) { const float ov = __shfl_xor(v1, of); const int oi = __shfl_xor(i1, of); if (ov > v1 || (ov == v1 && oi < i1)) { v1 = ov; i1 = oi; } }
                float v2 = (e == i1) ? -3.0e38f : lg; int i2 = e;
#pragma unroll
                for (int of = 1; of < 8; of <<= 1) { const float ov = __shfl_xor(v2, of); const int oi = __shfl_xor(i2, of); if (ov > v2 || (ov == v2 && oi < i2)) { v2 = ov; i2 = oi; } }
                if (lane < 16 && e == 0) { const int row = row0 + 2 * grp + (lane >> 3);
                    const float w1 = 1.0f / (1.0f + __expf(v2 - v1));
                    int* TI = (int*)(P.ws + WS_TOPI); float* TW = (float*)(P.ws + WS_TOPW);
                    TI[row * 2] = i1; TI[row * 2 + 1] = i2; TW[row * 2] = w1; TW[row * 2 + 1] = 1.0f - w1; }
                unsigned c = (i1 == e ? 1u : 0u) + (i2 == e ? 1u : 0u);
                c += __shfl_xor(c, 8);
                hcnt += c;
            }
        }
        if constexpr (ROUTER) { if (lane < 8) ((unsigned*)(P.ws + WS_WCNT))[(size_t)wi * 8 + lane] = hcnt; }
    }
    __syncthreads();
}

__device__ __forceinline__ void moe_scatter(const Params& P, unsigned char* lds, int bx, int G, int tid, int wave, int lane) {
    unsigned* ctl = (unsigned*)(P.ws + WS_CTL); const unsigned* WC = (const unsigned*)(P.ws + WS_WCNT);
    int* sh = (int*)lds;
    const int* TI = (const int*)(P.ws + WS_TOPI); int* DE = (int*)(P.ws + WS_DEST);
    const bf16* XN = (const bf16*)(P.ws + WS_XN); bf16* XG = (bf16*)(P.ws + WS_XG);
    constexpr int NWI = M / 8;
    if (tid < 16) sh[tid] = 0;
    __syncthreads();
    {
        unsigned a = 0; for (int i = tid; i < NWI * 8; i += NTHR) a += WC[i];
        atomicAdd(&sh[tid & 7], (int)a);
    }
    __syncthreads();
    int pstart[8]; { int acc = 0;
#pragma unroll
        for (int e = 0; e < 8; ++e) { pstart[e] = acc; acc += ((sh[e] + 255) >> 8) << 8; } }
    if (bx == 0 && tid < 8) ctl[CW_CNT + tid] = (unsigned)sh[tid];
    for (int wi0 = bx * NWAVES; wi0 < NWI; wi0 += G * NWAVES) {
        __syncthreads();
        if (tid < 8) sh[8 + tid] = 0;
        __syncthreads();
        { unsigned a = 0; for (int i = tid; i < wi0 * 8; i += NTHR) a += WC[i]; atomicAdd(&sh[8 + (tid & 7)], (int)a); }
        __syncthreads();
        const int wi = wi0 + wave;
        int base[8];
#pragma unroll
        for (int e = 0; e < 8; ++e) { int a = pstart[e] + sh[8 + e]; for (int w = wi0; w < wi; ++w) a += (int)WC[w * 8 + e]; base[e] = a; }
        for (int r = 0; r < 8; ++r) { const int row = wi * 8 + r;
            const u32x4 a = *(const u32x4*)(XN + (size_t)row * DM + 8 * lane), b2 = *(const u32x4*)(XN + (size_t)row * DM + 512 + 8 * lane);
#pragma unroll
            for (int k = 0; k < 2; ++k) { const int e = TI[row * 2 + k];
                int dest = 0;
#pragma unroll
                for (int q = 0; q < 8; ++q) { if (e == q) { dest = base[q]; base[q] += 1; } }
                if (lane == 0) DE[row * 2 + k] = dest;
                *(u32x4*)(XG + (size_t)dest * DM + 8 * lane) = a; *(u32x4*)(XG + (size_t)dest * DM + 512 + 8 * lane) = b2; } }
    }
    __syncthreads();
}

__device__ __forceinline__ void moe_combine_final(const Params& P, unsigned char* lds, int bx, int G, int tid, int wave, int lane) {
    const float* ada_b = P.in[3]; const float* MODP = (const float*)(P.ws + WS_MODP); const float* fg = P.in[22];
    const int* DE = (const int*)(P.ws + WS_DEST); const float* TW = (const float*)(P.ws + WS_TOPW); const float* YG = (const float*)(P.ws + WS_YG);
    float* mA = (float*)lds; float* mB = mA + 1024;
    for (int wi0 = bx * NWAVES; wi0 < M / 8; wi0 += G * NWAVES) {
        const int wi = wi0 + wave, row0 = wi * 8, b = (wi0 * 8) >> 12;
        __syncthreads();
        stage_mod2(ada_b, MODP, 1, b, 5120, 5120, mA, mB, tid);
        __syncthreads();
        f32x4 g2[4], g[4];
#pragma unroll
        for (int j = 0; j < 4; ++j) { const int col = 4 * lane + 256 * j; g2[j] = *(const f32x4*)(mA + col); g[j] = *(const f32x4*)(fg + col); }
        for (int r = 0; r < 8; ++r) { const int row = row0 + r; const int d0 = DE[row * 2], d1 = DE[row * 2 + 1]; const float w0 = TW[row * 2], w1 = TW[row * 2 + 1];
            float* xr = P.out + (size_t)row * DM + 4 * lane; f32x4 v[4]; float ss = 0.f;
#pragma unroll
            for (int j = 0; j < 4; ++j) { const f32x4 y0 = *(const f32x4*)(YG + (size_t)d0 * DM + 4 * lane + 256 * j), y1 = *(const f32x4*)(YG + (size_t)d1 * DM + 4 * lane + 256 * j);
                v[j] = *(const f32x4*)(xr + 256 * j) + g2[j] * (w0 * y0 + w1 * y1); ss += (v[j][0] * v[j][0] + v[j][1] * v[j][1]) + (v[j][2] * v[j][2] + v[j][3] * v[j][3]); }
            const float rs = rsqrtf(wave_sum(ss) * (1.0f / DM) + EPSN);
#pragma unroll
            for (int j = 0; j < 4; ++j) *(f32x4*)(xr + 256 * j) = v[j] * rs * g[j]; }
    }
    __syncthreads();
}

#define LAS __attribute__((address_space(3)))
#define XB_TMO      128
#define XB_XCNT(j)  (256  + 64 * (j))
#define XB_XSUB(j)  (1280 + 64 * (j))
#define XB_XGEN(j)  (2304 + 64 * (j))
#define XB_TOP      3328
#define XB_TOPGEN   3392
#define XCD_BAR_WORDS 3456
#define XB_SPIN_CAP (1u << 18)

__device__ __forceinline__ unsigned xb_ld(unsigned* p)              { return __hip_atomic_load(p, __ATOMIC_RELAXED, __HIP_MEMORY_SCOPE_AGENT); }
__device__ __forceinline__ unsigned xb_add(unsigned* p, unsigned v) { return __hip_atomic_fetch_add(p, v, __ATOMIC_RELAXED, __HIP_MEMORY_SCOPE_AGENT); }
__device__ __forceinline__ unsigned xb_xcc_id() { return (unsigned)__builtin_amdgcn_s_getreg((3 << 11) | 20) & 0xFu; }
#define XB_SPIN(cond, bar) do { unsigned _sp = 0; while (cond) { __builtin_amdgcn_s_sleep(1); \
    if ((++_sp & 255u) == 0u) { if (xb_ld(&(bar)[XB_TMO])) break; if (_sp > XB_SPIN_CAP) { atomicAdd(&(bar)[XB_TMO], 1u); break; } } } } while (0)

struct XcdBarrier {
    unsigned* bar; unsigned x;
    volatile LAS unsigned* st;
};

__device__ __forceinline__ XcdBarrier xcd_barrier_post(unsigned* bar, volatile LAS unsigned* st) {
    XcdBarrier b; b.bar = bar; b.x = xb_xcc_id(); b.st = st;
    if (threadIdx.x == 0) (void)xb_add(&bar[XB_XCNT(b.x)], 1u);
    return b;
}
__device__ __forceinline__ void xcd_barrier_complete(unsigned* bar, unsigned x, unsigned& nloc, unsigned& nx) {
    const unsigned G = gridDim.x * gridDim.y * gridDim.z;
    unsigned sum, cnt, mine, sp = 0u;
    for (;;) {
        sum = 0u; cnt = 0u; mine = 0u;
#pragma unroll
        for (unsigned j = 0; j < 16; ++j) { const unsigned c = xb_ld(&bar[XB_XCNT(j)]); sum += c; cnt += (c > 0u) ? 1u : 0u; mine = (j == x) ? c : mine; }
        if (sum == G) break;
        __builtin_amdgcn_s_sleep(1);
        if ((++sp & 255u) == 0u) { if (xb_ld(&bar[XB_TMO])) break; if (sp > XB_SPIN_CAP) { atomicAdd(&bar[XB_TMO], 1u); break; } }
    }
    nloc = mine > 0u ? mine : 1u; nx = cnt > 0u ? cnt : 1u;
}

__device__ __forceinline__ void xcd_barrier(const XcdBarrier& b) {
    asm volatile("s_waitcnt vmcnt(0)" ::: "memory");
    __syncthreads();
    if (threadIdx.x == 0) {
        unsigned* bar = b.bar;
        __builtin_amdgcn_s_waitcnt(0);
        unsigned nloc = b.st[0], nx = b.st[1];
        if (nloc == 0u) { xcd_barrier_complete(bar, b.x, nloc, nx); b.st[0] = nloc; b.st[1] = nx; }
        const unsigned old = xb_add(&bar[XB_XSUB(b.x)], 1u);
        const unsigned gen = old / nloc;
        if (old + 1u == (gen + 1u) * nloc) {
            __builtin_amdgcn_fence(__ATOMIC_RELEASE, "agent");
            asm volatile("s_waitcnt vmcnt(0)" ::: "memory");
            const unsigned og = xb_add(&bar[XB_TOP], 1u);
            const unsigned tg = og / nx;
            if (og + 1u == (tg + 1u) * nx) xb_add(&bar[XB_TOPGEN], 1u);
            else XB_SPIN(xb_ld(&bar[XB_TOPGEN]) == tg, bar);
            __builtin_amdgcn_fence(__ATOMIC_ACQUIRE, "agent");
            xb_add(&bar[XB_XGEN(b.x)], 1u);
            asm volatile("s_waitcnt vmcnt(0)" ::: "memory");
        } else {
            XB_SPIN(xb_ld(&bar[XB_XGEN(b.x)]) == gen, bar);
            __builtin_amdgcn_fence(__ATOMIC_ACQUIRE, "agent");
            asm volatile("s_waitcnt vmcnt(0)" ::: "memory");
        }
    }
    __syncthreads();
}

__device__ __forceinline__ f32x16 mfma32(bf16x8 a, bf16x8 b, f32x16 c) { return __builtin_amdgcn_mfma_f32_32x32x16_bf16(a, b, c, 0, 0, 0); }
__device__ __forceinline__ f32x4 mfma16(bf16x8 a, bf16x8 b, f32x4 c) { return __builtin_amdgcn_mfma_f32_16x16x32_bf16(a, b, c, 0, 0, 0); }
__device__ __forceinline__ int rowmap(int i, int hh) { return (i & 3) + 8 * (i >> 2) + 4 * hh; }
__device__ __forceinline__ bf16x8 ld8(const bf16* p) { return *(const bf16x8*)p; }
__device__ __forceinline__ bf16x8 ld44(const bf16* p) { const u32x2 lo = *(const u32x2*)p, hi = *(const u32x2*)(p + 8); u32x4 v; v.x = lo.x; v.y = lo.y; v.z = hi.x; v.w = hi.y; return __builtin_bit_cast(bf16x8, v); }
typedef short v4i16_t __attribute__((ext_vector_type(4)));
__device__ __forceinline__ bf16x8 ldtr8(const bf16* vb) {
    const v4i16_t lo = __builtin_amdgcn_ds_read_tr16_b64_v4i16((__attribute__((address_space(3))) v4i16_t*)vb);
    const v4i16_t hi = __builtin_amdgcn_ds_read_tr16_b64_v4i16((__attribute__((address_space(3))) v4i16_t*)(vb + 8 * 32));
    return (bf16x8){lo[0], lo[1], lo[2], lo[3], hi[0], hi[1], hi[2], hi[3]};
}
__device__ __forceinline__ bf16x8 pack8(const f32x16& p, int s) {
    u32x4 v; v.x = pk2(p[8 * s], p[8 * s + 1]); v.y = pk2(p[8 * s + 2], p[8 * s + 3]); v.z = pk2(p[8 * s + 4], p[8 * s + 5]); v.w = pk2(p[8 * s + 6], p[8 * s + 7]);
    return __builtin_bit_cast(bf16x8, v);
}
__device__ __forceinline__ float wave_scan_add(float v, int lane) {
#pragma unroll
    for (int o = 1; o < 64; o <<= 1) { const float t = __shfl_up(v, o); if (lane >= o) v += t; }
    return v;
}
__device__ __forceinline__ float wave_scan_max(float v, int lane) {
#pragma unroll
    for (int o = 1; o < 64; o <<= 1) { const float t = __shfl_up(v, o); if (lane >= o) v = fmaxf(v, t); }
    return v;
}

__device__ __forceinline__ void compress_unit(const Params& P, unsigned char* lds, int l, int u, int tid) {
    asm volatile("" : "+v"(tid));
    const int j = u >> 7, b = (u >> 5) & 3, g = (u >> 4) & 1, nb = u & 15, lj = l * 2 + j;
    const int wave = tid >> 6, lane = tid & 63;
    bf16* T = (bf16*)lds;
    float* Hs = (float*)(lds + 272 * 144);
    const bf16* PROJ = (const bf16*)(P.ws + WS_PROJ);
    for (int idx = tid; idx < 272 * 8; idx += NTHR) { const int row = idx >> 3, ch = idx & 7, tok = 256 * nb + row;
        u32x4 v = {0u, 0u, 0u, 0u};
        if (tok < SEQ) v = *(const u32x4*)(PROJ + (size_t)(b * SEQ + tok) * PLD + C_KV + j * 128 + g * 64 + ch * 8);
        *(u32x4*)(T + ((row & 15) * 17 + (row >> 4)) * 72 + ch * 8) = v; }
    __syncthreads();
    {
        f32x4 acc = {0.f, 0.f, 0.f, 0.f};
        const bf16* wrow = (const bf16*)(P.ws + WS_W1T) + ((size_t)lj * 128 + 16 * wave + (lane & 15)) * 2048 + 8 * (lane >> 4);
        const bf16* arow = T + (lane & 15) * 72 + 8 * (lane >> 4);
#pragma unroll 16
        for (int st = 0; st < 64; ++st) { const int p_ = st >> 1; const bf16x8 a = ld8(arow + ((p_ & 15) * 17 + (p_ >> 4)) * 72 + 32 * (st & 1)); const bf16x8 bb = ld8(wrow + 32 * st); acc = mfma16(a, bb, acc); }
        const int hid = 16 * wave + (lane & 15);
        float c1 = 0.f; const float* c1p = (const float*)(P.ws + WS_C1P) + (size_t)lj * 16 * 128 + hid;
#pragma unroll
        for (int kc = 0; kc < 16; ++kc) c1 += c1p[kc * 128];
#pragma unroll
        for (int r = 0; r < 4; ++r) Hs[(4 * (lane >> 4) + r) * 128 + hid] = siluf_(acc[r] + c1);
    }
    __syncthreads();
    {
        const int n = tid >> 5, dd = (tid & 31) * 2; const float* w2 = P.in[10] + (size_t)lj * 128 * 64 + dd; const float* hs = Hs + n * 128;
        float o0 = 0.f, o1 = 0.f;
#pragma unroll 8
        for (int h = 0; h < 128; ++h) { const float x = hs[h]; o0 += x * w2[h * 64]; o1 += x * w2[h * 64 + 1]; }
        const int ng = 16 * nb + n; if (ng == 255) { o0 = 0.f; o1 = 0.f; }
        bf16* KC = (bf16*)(P.ws + WS_KC) + ((size_t)((j * 4 + b) * 2 + g) * 256 + ng) * 64 + dd;
        *(unsigned*)KC = pk2(o0, o1);
    }
    __syncthreads();
}

__device__ __forceinline__ void conv16(const Params& P, int l, int b, int t, int col0, int cch0, float scale, float (&out)[16]) {
    const bf16* PROJ = (const bf16*)(P.ws + WS_PROJ);
    const float* cw = P.in[11] + (size_t)l * 4 * 1024 + cch0; const float* cb = P.in[12] + (size_t)l * 1024 + cch0;
#pragma unroll
    for (int q = 0; q < 4; ++q) { const f32x4 bb = *(const f32x4*)(cb + 4 * q); out[4 * q] = bb[0]; out[4 * q + 1] = bb[1]; out[4 * q + 2] = bb[2]; out[4 * q + 3] = bb[3]; }
#pragma unroll
    for (int i = 0; i < 4; ++i) { const int tt = t - 3 + i;
        if (tt >= 0) { const bf16* xr = PROJ + (size_t)(b * SEQ + tt) * PLD + col0; const u32x4 x0 = *(const u32x4*)xr, x1 = *(const u32x4*)(xr + 8);
            const unsigned xs[8] = {x0.x, x0.y, x0.z, x0.w, x1.x, x1.y, x1.z, x1.w};
#pragma unroll
            for (int q = 0; q < 4; ++q) { const f32x4 w = *(const f32x4*)(cw + i * 1024 + 4 * q);
                out[4 * q] += w[0] * bf2f(xs[2 * q] & 0xffffu); out[4 * q + 1] += w[1] * bf2f(xs[2 * q] >> 16); out[4 * q + 2] += w[2] * bf2f(xs[2 * q + 1] & 0xffffu); out[4 * q + 3] += w[3] * bf2f(xs[2 * q + 1] >> 16); } } }
#pragma unroll
    for (int q = 0; q < 16; ++q) out[q] = siluf_(out[q]) * scale;
}

__device__ __forceinline__ void mlstm_local_unit(const Params& P, unsigned char* lds, int l, int u, int tid) {
    asm volatile("" : "+v"(tid));
    const int bh = u >> 6, c = u & 63, b = bh >> 2, h = bh & 3, wave = tid >> 6, lane = tid & 63, r32 = lane & 31, hh = lane >> 5;
    bf16* Kt = (bf16*)lds;
    bf16* Vt = (bf16*)(lds + 18432);
    float* wS = (float*)(lds + 36864);
    const float* GATES = (const float*)(P.ws + WS_GATES); const bf16* PROJ = (const bf16*)(P.ws + WS_PROJ);
    const int tok0 = 64 * c;
    if (wave == 0) {
        const float* gr = GATES + (size_t)(b * SEQ + tok0 + lane) * 32;
        const float lf = logsigmoidf_(gr[28 + h]), ig = gr[24 + h];
        const float a = wave_scan_add(lf, lane), aL = __shfl(a, 63);
        const float lw = aL - a + ig, ml = wave_max(lw);
        wS[lane] = __expf(lw - ml);
        if (lane == 0) { float* SC = (float*)(P.ws + WS_SC); SC[u * 2] = aL; SC[u * 2 + 1] = ml; }
    }
    __syncthreads();
    {
        const int s = tid >> 3, ch = tid & 7, d0 = 16 * ch; float kv[16];
        conv16(P, l, b, tok0 + s, C_QKM + 512 + h * 128 + d0, 512 + h * 128 + d0, 0.08838834764831845f, kv);
#pragma unroll
        for (int q = 0; q < 16; ++q) Kt[(d0 + q) * 72 + s] = (bf16)f2bf(kv[q]);
        {
            bf16* kq = (bf16*)(P.ws + WS_XN) + (size_t)(b * SEQ + tok0 + s) * DM + h * 128 + d0; u32x4 w0, w1;
            w0.x = pk2(kv[0], kv[1]); w0.y = pk2(kv[2], kv[3]); w0.z = pk2(kv[4], kv[5]); w0.w = pk2(kv[6], kv[7]); w1.x = pk2(kv[8], kv[9]); w1.y = pk2(kv[10], kv[11]); w1.z = pk2(kv[12], kv[13]); w1.w = pk2(kv[14], kv[15]);
            *(u32x4*)(kq + 512) = w0; *(u32x4*)(kq + 520) = w1;
            float qv[16]; conv16(P, l, b, tok0 + s, C_QKM + h * 128 + d0, h * 128 + d0, 1.0f, qv);
            w0.x = pk2(qv[0], qv[1]); w0.y = pk2(qv[2], qv[3]); w0.z = pk2(qv[4], qv[5]); w0.w = pk2(qv[6], qv[7]); w1.x = pk2(qv[8], qv[9]); w1.y = pk2(qv[10], qv[11]); w1.z = pk2(qv[12], qv[13]); w1.w = pk2(qv[14], qv[15]);
            *(u32x4*)(kq) = w0; *(u32x4*)(kq + 8) = w1; }
        const bf16* vr = PROJ + (size_t)(b * SEQ + tok0 + s) * PLD + C_VM + h * 128 + d0; const u32x4 x0 = *(const u32x4*)vr, x1 = *(const u32x4*)(vr + 8);
        const unsigned xs[8] = {x0.x, x0.y, x0.z, x0.w, x1.x, x1.y, x1.z, x1.w}; const float w = wS[s];
#pragma unroll
        for (int q = 0; q < 8; ++q) { Vt[(d0 + 2 * q) * 72 + s] = (bf16)f2bf(bf2f(xs[q] & 0xffffu) * w); Vt[(d0 + 2 * q + 1) * 72 + s] = (bf16)f2bf(bf2f(xs[q] >> 16) * w); }
    }
    __syncthreads();
    {
        const int et = wave >> 1, dt0 = 2 * (wave & 1);
        f32x16 acc0 = {}, acc1 = {};
#pragma unroll
        for (int st = 0; st < 4; ++st) { const bf16x8 a = ld8(Vt + (32 * et + r32) * 72 + 16 * st + 8 * hh);
            acc0 = mfma32(a, ld8(Kt + (32 * dt0 + r32) * 72 + 16 * st + 8 * hh), acc0);
            acc1 = mfma32(a, ld8(Kt + (32 * (dt0 + 1) + r32) * 72 + 16 * st + 8 * hh), acc1); }
        float* LC = (float*)(P.ws + WS_LC) + (size_t)u * 16384;
#pragma unroll
        for (int i = 0; i < 16; ++i) { const int e = 32 * et + rowmap(i, hh); LC[e * 128 + 32 * dt0 + r32] = acc0[i]; LC[e * 128 + 32 * (dt0 + 1) + r32] = acc1[i]; }
    }
    if (tid < 128) { float nl = 0.f;
#pragma unroll 8
        for (int s = 0; s < 64; ++s) nl += wS[s] * bf2f(Kt[tid * 72 + s]);
        ((float*)(P.ws + WS_NL))[u * 128 + tid] = nl; }
    __syncthreads();
}

__device__ __forceinline__ void mlstm_scan(const Params& P, int bx, int G, int tid, int wave, int lane) {
    const float* __restrict__ LC = (const float*)(P.ws + WS_LC); const float* __restrict__ NL = (const float*)(P.ws + WS_NL); const float* __restrict__ SC = (const float*)(P.ws + WS_SC);
    bf16* __restrict__ CP = (bf16*)(P.ws + WS_CP); float* __restrict__ NP = (float*)(P.ws + WS_NP); float* __restrict__ MP = (float*)(P.ws + WS_MP);
    typedef float f32x2s __attribute__((ext_vector_type(2)));
    for (int gt = bx * NTHR + tid; gt < 16 * 8192; gt += G * NTHR) {
        const int bh = gt >> 13, el = (gt & 8191) * 2;
        f32x2s C = {0.f, 0.f}; float m = 0.f;
        for (int c0 = 0; c0 < 64; c0 += 16) {
            f32x2s Lv[16]; float aL[16], ml[16];
#pragma unroll
            for (int k = 0; k < 16; ++k) { const int u = bh * 64 + c0 + k; Lv[k] = *(const f32x2s*)(LC + (size_t)u * 16384 + el); aL[k] = SC[u * 2]; ml[k] = SC[u * 2 + 1]; }
#pragma unroll
            for (int k = 0; k < 16; ++k) { const int u = bh * 64 + c0 + k;
                *(unsigned*)(CP + (size_t)u * 16384 + el) = pk2(C[0], C[1]);
                if (el == 0) MP[u] = m;
                const float mn = fmaxf(aL[k] + m, ml[k]), f1 = __expf(aL[k] + m - mn), f2 = __expf(ml[k] - mn);
                C = f1 * C + f2 * Lv[k]; m = mn; }
        }
    }
    if (wave == 7) {
        for (int gi = bx * 64 + lane; gi < 16 * 128; gi += G * 64) {
            const int bh = gi >> 7, d = gi & 127; float C = 0.f, m = 0.f;
            for (int c0 = 0; c0 < 64; c0 += 16) {
                float Lv[16], aL[16], ml[16];
#pragma unroll
                for (int k = 0; k < 16; ++k) { const int u = bh * 64 + c0 + k; Lv[k] = NL[u * 128 + d]; aL[k] = SC[u * 2]; ml[k] = SC[u * 2 + 1]; }
#pragma unroll
                for (int k = 0; k < 16; ++k) { const int u = bh * 64 + c0 + k;
                    NP[u * 128 + d] = C;
                    const float mn = fmaxf(aL[k] + m, ml[k]);
                    C = __expf(aL[k] + m - mn) * C + __expf(ml[k] - mn) * Lv[k]; m = mn; }
            }
        }
    }
}

__device__ __forceinline__ void mlstm_out_unit(const Params& P, unsigned char* lds, int l, int u, int tid) {
    asm volatile("" : "+v"(tid));
    const int bh = u >> 6, c = u & 63, b = bh >> 2, h = bh & 3, wave = tid >> 6, lane = tid & 63, r32 = lane & 31, hh = lane >> 5;
    bf16* Qs = (bf16*)lds;
    bf16* Ks = (bf16*)(lds + 17408);
    bf16* Vt = (bf16*)(lds + 34816);
    float* aS = (float*)(lds + 53248);
    float* bS = aS + 64;
    float* GS = aS + 128;
    float* nq = aS + 192;
    float* ssq = aS + 256;
    const float* GATES = (const float*)(P.ws + WS_GATES); const bf16* PROJ = (const bf16*)(P.ws + WS_PROJ);
    const int tok0 = 64 * c; const float mprev = ((const float*)(P.ws + WS_MP))[u];
    if (wave == 0) {
        const float* gr = GATES + (size_t)(b * SEQ + tok0 + lane) * 32;
        const float lf = logsigmoidf_(gr[28 + h]), ig = gr[24 + h];
        const float a = wave_scan_add(lf, lane), bb = ig - a, pm = wave_scan_max(bb, lane);
        aS[lane] = a; bS[lane] = bb; GS[lane] = fmaxf(mprev, pm);
    }
    {
        const int s = tid >> 3, ch = tid & 7, d0 = 16 * ch; float qv[16], kv[16];
        conv16(P, l, b, tok0 + s, C_QKM + h * 128 + d0, h * 128 + d0, 1.0f, qv);
        conv16(P, l, b, tok0 + s, C_QKM + 512 + h * 128 + d0, 512 + h * 128 + d0, 0.08838834764831845f, kv);
        u32x4 w0, w1;
        w0.x = pk2(qv[0], qv[1]); w0.y = pk2(qv[2], qv[3]); w0.z = pk2(qv[4], qv[5]); w0.w = pk2(qv[6], qv[7]); w1.x = pk2(qv[8], qv[9]); w1.y = pk2(qv[10], qv[11]); w1.z = pk2(qv[12], qv[13]); w1.w = pk2(qv[14], qv[15]);
        *(u32x4*)(Qs + s * 136 + d0) = w0; *(u32x4*)(Qs + s * 136 + d0 + 8) = w1;
        w0.x = pk2(kv[0], kv[1]); w0.y = pk2(kv[2], kv[3]); w0.z = pk2(kv[4], kv[5]); w0.w = pk2(kv[6], kv[7]); w1.x = pk2(kv[8], kv[9]); w1.y = pk2(kv[10], kv[11]); w1.z = pk2(kv[12], kv[13]); w1.w = pk2(kv[14], kv[15]);
        *(u32x4*)(Ks + s * 136 + d0) = w0; *(u32x4*)(Ks + s * 136 + d0 + 8) = w1;
        const bf16* vr = PROJ + (size_t)(b * SEQ + tok0 + s) * PLD + C_VM + h * 128 + d0; const u32x4 x0 = *(const u32x4*)vr, x1 = *(const u32x4*)(vr + 8);
        const unsigned xs[8] = {x0.x, x0.y, x0.z, x0.w, x1.x, x1.y, x1.z, x1.w};
#pragma unroll
        for (int q = 0; q < 8; ++q) { Vt[(d0 + 2 * q) * 72 + s] = (bf16)(xs[q] & 0xffffu); Vt[(d0 + 2 * q + 1) * 72 + s] = (bf16)(xs[q] >> 16); }
    }
    __syncthreads();
    {
        const int jq = tid >> 3, part = tid & 7; const float* np = (const float*)(P.ws + WS_NP) + (size_t)u * 128 + part * 16; float a = 0.f;
#pragma unroll
        for (int d = 0; d < 16; ++d) a += np[d] * bf2f(Qs[jq * 136 + part * 16 + d]);
        a += __shfl_xor(a, 1); a += __shfl_xor(a, 2); a += __shfl_xor(a, 4);
        if (part == 0) nq[jq] = a;
    }
    __syncthreads();
    const int et = wave >> 1, jt = wave & 1, jl = 32 * jt + r32;
    bf16x8 qf[8];
#pragma unroll
    for (int st = 0; st < 8; ++st) qf[st] = ld8(Qs + jl * 136 + 16 * st + 8 * hh);
    const float Gj = GS[jl], inter = __expf(mprev - Gj);
    f32x16 acc = {};
    {
        const bf16* cp = (const bf16*)(P.ws + WS_CP) + (size_t)u * 16384 + (32 * et + r32) * 128 + 8 * hh;
#pragma unroll
        for (int st = 0; st < 8; ++st) acc = mfma32(ld8(cp + 16 * st), qf[st], acc);
#pragma unroll
        for (int i = 0; i < 16; ++i) acc[i] *= inter;
    }
    float colsum = 0.f;
#pragma unroll
    for (int kt = 0; kt < 2; ++kt) {
        if (kt <= jt) {
            f32x16 sd = {};
#pragma unroll
            for (int st = 0; st < 8; ++st) sd = mfma32(ld8(Ks + (32 * kt + r32) * 136 + 16 * st + 8 * hh), qf[st], sd);
#pragma unroll
            for (int i = 0; i < 16; ++i) { const int s = 32 * kt + rowmap(i, hh); const float dv = (s <= jl) ? __expf(bS[s] - Gj) : 0.f; sd[i] *= dv; colsum += sd[i]; }
#pragma unroll
            for (int s2 = 0; s2 < 2; ++s2) acc = mfma32(ld44(Vt + (32 * et + r32) * 72 + 32 * kt + 16 * s2 + 4 * hh), pack8(sd, s2), acc);
        }
    }
    colsum += __shfl_xor(colsum, 32);
    const float den = inter * nq[jl] + colsum, dn = fmaxf(fabsf(den), __expf(-(aS[jl] + Gj))), rdn = 1.0f / dn;
    const int trow = b * SEQ + tok0 + jl;
    float part = 0.f;
#pragma unroll
    for (int q = 0; q < 4; ++q) { const int e0 = 32 * et + 8 * q + 4 * hh;
        const u32x2 ov = *(const u32x2*)(PROJ + (size_t)trow * PLD + C_OM + h * 128 + e0);
        const float o0 = bf2f(ov.x & 0xffffu), o1 = bf2f(ov.x >> 16), o2 = bf2f(ov.y & 0xffffu), o3 = bf2f(ov.y >> 16);
        acc[4 * q] *= rdn * sigmoidf_(o0); acc[4 * q + 1] *= rdn * sigmoidf_(o1); acc[4 * q + 2] *= rdn * sigmoidf_(o2); acc[4 * q + 3] *= rdn * sigmoidf_(o3);
        part += acc[4 * q] * acc[4 * q] + acc[4 * q + 1] * acc[4 * q + 1] + acc[4 * q + 2] * acc[4 * q + 2] + acc[4 * q + 3] * acc[4 * q + 3]; }
    part += __shfl_xor(part, 32);
    if (hh == 0) ssq[et * 64 + jl] = part;
    __syncthreads();
    const float tot = ssq[jl] + ssq[64 + jl] + ssq[128 + jl] + ssq[192 + jl], rstd = rsqrtf(tot * (1.0f / 128.0f) + EPSN);
    const float* ng = P.in[13] + (size_t)l * 512 + h * 128; bf16* Y = (bf16*)(P.ws + WS_Y) + (size_t)trow * DM + 512 + h * 128;
#pragma unroll
    for (int q = 0; q < 4; ++q) { const int e0 = 32 * et + 8 * q + 4 * hh; const f32x4 gg = *(const f32x4*)(ng + e0);
        u32x2 w; w.x = pk2(acc[4 * q] * rstd * gg[0], acc[4 * q + 1] * rstd * gg[1]); w.y = pk2(acc[4 * q + 2] * rstd * gg[2], acc[4 * q + 3] * rstd * gg[3]);
        *(u32x2*)(Y + e0) = w; }
    __syncthreads();
}

__device__ __forceinline__ int tb_off(int row, int col) { return (col >> 5) * 2048 + row * 32 + (col & 31); }
__device__ __forceinline__ bf16x8 ldtr_nat(const bf16* tile, int cb, int s0, int lane) {
    const bf16* p = tile + cb * 2048 + (s0 + 8 * (lane >> 5) + ((lane & 15) >> 2)) * 32 + 16 * ((lane >> 4) & 1) + 4 * (lane & 3);
    const v4i16_t lo = __builtin_amdgcn_ds_read_tr16_b64_v4i16((__attribute__((address_space(3))) v4i16_t*)p);
    const v4i16_t hi = __builtin_amdgcn_ds_read_tr16_b64_v4i16((__attribute__((address_space(3))) v4i16_t*)(p + 4 * 32));
    return (bf16x8){lo[0], lo[1], lo[2], lo[3], hi[0], hi[1], hi[2], hi[3]};
}
__device__ __forceinline__ void mlstm_local_wave(const Params& P, unsigned char* ldsw, float* wS, int l, int u, int lane) {
    const int bh = u >> 6, c = u & 63, b = bh >> 2, h = bh & 3, r32 = lane & 31, hh = lane >> 5, tok0 = 64 * c;
    bf16* Kt = (bf16*)ldsw; bf16* Vb = (bf16*)(ldsw + 16384);
    const float* GATES = (const float*)(P.ws + WS_GATES); const bf16* PROJ = (const bf16*)(P.ws + WS_PROJ); bf16* KQC = (bf16*)(P.ws + WS_XN);
    {
        const float* gr = GATES + (size_t)(b * SEQ + tok0 + lane) * 32;
        const float lf = logsigmoidf_(gr[28 + h]), ig = gr[24 + h];
        const float a = wave_scan_add(lf, lane), aL = __shfl(a, 63);
        const float lw = aL - a + ig, ml = wave_max(lw);
        wS[lane] = __expf(lw - ml);
        if (lane == 0) { float* SC = (float*)(P.ws + WS_SC); SC[u * 2] = aL; SC[u * 2 + 1] = ml; }
    }
#pragma unroll 1
    for (int it = 0; it < 8; ++it) {
        const int row = it * 8 + (lane >> 3), d0 = 16 * (lane & 7); float kv[16];
        bf16* kq = KQC + (size_t)(b * SEQ + tok0 + row) * DM + h * 128 + d0;
        conv16(P, l, b, tok0 + row, C_QKM + 512 + h * 128 + d0, 512 + h * 128 + d0, 0.08838834764831845f, kv);
        u32x4 w0, w1;
        w0.x = pk2(kv[0], kv[1]); w0.y = pk2(kv[2], kv[3]); w0.z = pk2(kv[4], kv[5]); w0.w = pk2(kv[6], kv[7]); w1.x = pk2(kv[8], kv[9]); w1.y = pk2(kv[10], kv[11]); w1.z = pk2(kv[12], kv[13]); w1.w = pk2(kv[14], kv[15]);
        *(u32x4*)(Kt + tb_off(row, d0)) = w0; *(u32x4*)(Kt + tb_off(row, d0 + 8)) = w1;
        *(u32x4*)(kq + 512) = w0; *(u32x4*)(kq + 520) = w1;
        conv16(P, l, b, tok0 + row, C_QKM + h * 128 + d0, h * 128 + d0, 1.0f, kv);
        w0.x = pk2(kv[0], kv[1]); w0.y = pk2(kv[2], kv[3]); w0.z = pk2(kv[4], kv[5]); w0.w = pk2(kv[6], kv[7]); w1.x = pk2(kv[8], kv[9]); w1.y = pk2(kv[10], kv[11]); w1.z = pk2(kv[12], kv[13]); w1.w = pk2(kv[14], kv[15]);
        *(u32x4*)(kq) = w0; *(u32x4*)(kq + 8) = w1;
    }
    LDS_WAIT();
    float* LC = (float*)(P.ws + WS_LC) + (size_t)u * 16384;
#pragma unroll 1
    for (int eb = 0; eb < 4; ++eb) {
#pragma unroll
        for (int it = 0; it < 4; ++it) { const int row = it * 16 + (lane >> 2), pc = lane & 3;
            const u32x4 x = *(const u32x4*)(PROJ + (size_t)(b * SEQ + tok0 + row) * PLD + C_VM + h * 128 + 32 * eb + 8 * pc); const float w = wS[row];
            u32x4 y; y.x = pk2(bf2f(x.x & 0xffffu) * w, bf2f(x.x >> 16) * w); y.y = pk2(bf2f(x.y & 0xffffu) * w, bf2f(x.y >> 16) * w); y.z = pk2(bf2f(x.z & 0xffffu) * w, bf2f(x.z >> 16) * w); y.w = pk2(bf2f(x.w & 0xffffu) * w, bf2f(x.w >> 16) * w);
            *(u32x4*)(Vb + row * 32 + 8 * pc) = y; }
        LDS_WAIT();
        f32x16 acc[4]; acc[0] = f32x16{}; acc[1] = f32x16{}; acc[2] = f32x16{}; acc[3] = f32x16{};
#pragma unroll
        for (int st = 0; st < 4; ++st) { const bf16x8 a = ldtr_nat(Vb, 0, 16 * st, lane);
#pragma unroll
            for (int db = 0; db < 4; ++db) acc[db] = mfma32(a, ldtr_nat(Kt, db, 16 * st, lane), acc[db]); }
#pragma unroll
        for (int db = 0; db < 4; ++db)
#pragma unroll
            for (int i = 0; i < 16; ++i) LC[(32 * eb + rowmap(i, hh)) * 128 + 32 * db + r32] = acc[db][i];
        LDS_WAIT();
    }
    {
        float n0 = 0.f, n1 = 0.f;
#pragma unroll 8
        for (int s = 0; s < 64; ++s) { const float w = wS[s]; n0 += w * bf2f(Kt[tb_off(s, lane)]); n1 += w * bf2f(Kt[tb_off(s, lane + 64)]); }
        float* NL = (float*)(P.ws + WS_NL) + (size_t)u * 128; NL[lane] = n0; NL[lane + 64] = n1;
    }
    LDS_WAIT();
}
__device__ __forceinline__ void mlstm_out_wave(const Params& P, unsigned char* ldsw, float* sc, int l, int uu, int lane) {
    const int u = uu >> 1, jt = uu & 1, bh = u >> 6, c = u & 63, b = bh >> 2, h = bh & 3, r32 = lane & 31, hh = lane >> 5, tok0 = 64 * c;
    bf16* Vt = (bf16*)ldsw; float* aS = sc; float* bS = sc + 64; float* GS = sc + 128;
    const float* GATES = (const float*)(P.ws + WS_GATES); const bf16* PROJ = (const bf16*)(P.ws + WS_PROJ); const bf16* KQC = (const bf16*)(P.ws + WS_XN);
    const float mprev = ((const float*)(P.ws + WS_MP))[u];
    {
        const float* gr = GATES + (size_t)(b * SEQ + tok0 + lane) * 32;
        const float lf = logsigmoidf_(gr[28 + h]), ig = gr[24 + h];
        const float a = wave_scan_add(lf, lane), bb = ig - a, pm = wave_scan_max(bb, lane);
        aS[lane] = a; bS[lane] = bb; GS[lane] = fmaxf(mprev, pm);
    }
    const int nrow = 32 * (jt + 1);
#pragma unroll 1
    for (int it = 0; it < nrow / 8; ++it) { const int row = it * 8 + (lane >> 3), d0 = 16 * (lane & 7);
        const bf16* vr = PROJ + (size_t)(b * SEQ + tok0 + row) * PLD + C_VM + h * 128 + d0;
        const u32x4 x0 = *(const u32x4*)vr, x1 = *(const u32x4*)(vr + 8);
        *(u32x4*)(Vt + tb_off(row, d0)) = x0; *(u32x4*)(Vt + tb_off(row, d0 + 8)) = x1; }
    LDS_WAIT();
    const int jl = 32 * jt + r32, trow = b * SEQ + tok0 + jl;
    bf16x8 qf[8];
    { const bf16* qrow = KQC + (size_t)trow * DM + h * 128 + 8 * hh;
#pragma unroll
        for (int st = 0; st < 8; ++st) qf[st] = ld8(qrow + 16 * st); }
    const float Gj = GS[jl], inter = __expf(mprev - Gj);
    float nq = 0.f;
    { const float* np = (const float*)(P.ws + WS_NP) + (size_t)u * 128 + 8 * hh;
#pragma unroll
        for (int st = 0; st < 8; ++st) { const f32x4 n0 = *(const f32x4*)(np + 16 * st), n1 = *(const f32x4*)(np + 16 * st + 4); const u32x4 qq = __builtin_bit_cast(u32x4, qf[st]);
            nq += n0[0] * bf2f(qq.x & 0xffffu) + n0[1] * bf2f(qq.x >> 16) + n0[2] * bf2f(qq.y & 0xffffu) + n0[3] * bf2f(qq.y >> 16)
                + n1[0] * bf2f(qq.z & 0xffffu) + n1[1] * bf2f(qq.z >> 16) + n1[2] * bf2f(qq.w & 0xffffu) + n1[3] * bf2f(qq.w >> 16); }
        nq += __shfl_xor(nq, 32); }
    bf16x8 pb[2][2]; float colsum = 0.f;
#pragma unroll
    for (int kt = 0; kt < 2; ++kt) {
        f32x16 sd = {};
        if (kt <= jt) {
            const bf16* krow = KQC + (size_t)(b * SEQ + tok0 + 32 * kt + r32) * DM + 512 + h * 128 + 8 * hh;
#pragma unroll
            for (int st = 0; st < 8; ++st) sd = mfma32(ld8(krow + 16 * st), qf[st], sd);
#pragma unroll
            for (int i = 0; i < 16; ++i) { const int s = 32 * kt + rowmap(i, hh); const float bsv = bS[s]; const float ev = __builtin_amdgcn_exp2f((bsv - Gj) * LOG2E); const float dv = (s <= jl) ? ev : 0.f; sd[i] *= dv; colsum += sd[i]; }
        }
        pb[kt][0] = pack8(sd, 0); pb[kt][1] = pack8(sd, 1);
        asm volatile("" ::: "memory");
    }
    f32x16 acc[4];
#pragma unroll
    for (int et = 0; et < 4; ++et) { acc[et] = f32x16{};
        const bf16* cp = (const bf16*)(P.ws + WS_CP) + (size_t)u * 16384 + (32 * et + r32) * 128 + 8 * hh;
#pragma unroll
        for (int st = 0; st < 8; ++st) acc[et] = mfma32(ld8(cp + 16 * st), qf[st], acc[et]);
#pragma unroll
        for (int i = 0; i < 16; ++i) acc[et][i] *= inter;
#pragma unroll
        for (int kt = 0; kt < 2; ++kt) { if (kt <= jt) {
#pragma unroll
            for (int s2 = 0; s2 < 2; ++s2) { const bf16* vb_ = Vt + et * 2048 + (32 * kt + 16 * s2 + 4 * hh + ((r32 & 15) >> 2)) * 32 + 16 * (r32 >> 4) + 4 * (r32 & 3);
                acc[et] = mfma32(ldtr8(vb_), pb[kt][s2], acc[et]); } } }
        asm volatile("" ::: "memory"); }
    colsum += __shfl_xor(colsum, 32);
    const float den = inter * nq + colsum, dn = fmaxf(fabsf(den), __expf(-(aS[jl] + Gj))), rdn = 1.0f / dn;
    float part = 0.f;
#pragma unroll
    for (int et = 0; et < 4; ++et)
#pragma unroll
        for (int q = 0; q < 4; ++q) { const int e0 = 32 * et + 8 * q + 4 * hh;
            const u32x2 ov = *(const u32x2*)(PROJ + (size_t)trow * PLD + C_OM + h * 128 + e0);
            const float o0 = bf2f(ov.x & 0xffffu), o1 = bf2f(ov.x >> 16), o2 = bf2f(ov.y & 0xffffu), o3 = bf2f(ov.y >> 16);
            acc[et][4 * q] *= rdn * sigmoidf_(o0); acc[et][4 * q + 1] *= rdn * sigmoidf_(o1); acc[et][4 * q + 2] *= rdn * sigmoidf_(o2); acc[et][4 * q + 3] *= rdn * sigmoidf_(o3);
            part += acc[et][4 * q] * acc[et][4 * q] + acc[et][4 * q + 1] * acc[et][4 * q + 1] + acc[et][4 * q + 2] * acc[et][4 * q + 2] + acc[et][4 * q + 3] * acc[et][4 * q + 3];
            if (q == 3) asm volatile("" ::: "memory"); }
    part += __shfl_xor(part, 32);
    const float rstd = rsqrtf(part * (1.0f / 128.0f) + EPSN);
    const float* ng = P.in[13] + (size_t)l * 512 + h * 128; bf16* Y = (bf16*)(P.ws + WS_Y) + (size_t)trow * DM + 512 + h * 128;
#pragma unroll
    for (int et = 0; et < 4; ++et)
#pragma unroll
        for (int q = 0; q < 4; ++q) { const int e0 = 32 * et + 8 * q + 4 * hh; const f32x4 gg = *(const f32x4*)(ng + e0);
            u32x2 w; w.x = pk2(acc[et][4 * q] * rstd * gg[0], acc[et][4 * q + 1] * rstd * gg[1]); w.y = pk2(acc[et][4 * q + 2] * rstd * gg[2], acc[et][4 * q + 3] * rstd * gg[3]);
            *(u32x2*)(Y + e0) = w; }
    LDS_WAIT();
}

constexpr int AL_KSC = 0, AL_KS = 36864, AL_VT = 73728, AL_IMPM = 36864, AL_IMPS = 53248, AL_SELB = 106496;
template <int MODE>
__device__ __forceinline__ void attn_tile(const bf16* Kt_, const bf16* Vt_, const bf16x8 (&qf)[4], f32x16 (&o)[2], float& m, float& l, float invl, int t, float slope2,
                                          int pos0, int posmul, bool lane_sel, float* IMPm, float* IMPs, int tokl, int jb, int r32, int hh) {
    f32x16 s[2]; s[0] = f32x16{}; s[1] = f32x16{};
#pragma unroll
    for (int st = 0; st < 4; ++st) { s[0] = mfma32(ld8(Kt_ + r32 * 72 + 16 * st + 8 * hh), qf[st], s[0]); s[1] = mfma32(ld8(Kt_ + (32 + r32) * 72 + 16 * st + 8 * hh), qf[st], s[1]); }
    const float C1 = 0.125f * LOG2E;
    float mx = -1.0e30f;
#pragma unroll
    for (int kt = 0; kt < 2; ++kt)
#pragma unroll
        for (int i = 0; i < 16; ++i) { const int keyl = 32 * kt + rowmap(i, hh); const int dist = t - (pos0 + posmul * keyl);
            bool valid = dist >= 0; if (MODE == 3) valid = valid && dist < 512; if (MODE == 2) valid = valid && lane_sel;
            const float v = valid ? (s[kt][i] * C1 - slope2 * (float)dist) : -1.0e30f; s[kt][i] = v; mx = fmaxf(mx, v); }
    if (MODE != 1) {
        mx = fmaxf(mx, __shfl_xor(mx, 32));
        const float mn = fmaxf(m, mx), alpha = __builtin_amdgcn_exp2f(m - mn); m = mn; l *= alpha;
        if (MODE >= 2) {
#pragma unroll
            for (int i = 0; i < 16; ++i) { o[0][i] *= alpha; o[1][i] *= alpha; } }
    }
    float ps = 0.f;
#pragma unroll
    for (int kt = 0; kt < 2; ++kt)
#pragma unroll
        for (int i = 0; i < 16; ++i) { const float v = s[kt][i]; float p = (v > -1.0e29f) ? __builtin_amdgcn_exp2f(v - m) : 0.f; if (MODE == 1) p *= invl; s[kt][i] = p; ps += p; }
    if (MODE != 1) l += ps;
    if (MODE == 0) return;
#pragma unroll
    for (int kt = 0; kt < 2; ++kt)
#pragma unroll
        for (int s2 = 0; s2 < 2; ++s2) { const bf16x8 pb = pack8(s[kt], s2);
            const bf16* vb_ = Vt_ + (32 * kt + 16 * s2 + 4 * hh + ((r32 & 15) >> 2)) * 32 + 16 * (r32 >> 4) + 4 * (r32 & 3);
            o[0] = mfma32(ldtr8(vb_), pb, o[0]);
            o[1] = mfma32(ldtr8(vb_ + 2048), pb, o[1]); }
    if (MODE == 1) {
#pragma unroll
        for (int kt = 0; kt < 2; ++kt)
#pragma unroll
            for (int q4 = 0; q4 < 4; ++q4) { float pp[4];
#pragma unroll
                for (int k = 0; k < 4; ++k) { float x = s[kt][4 * q4 + k]; x += __shfl_xor(x, 8); x += __shfl_xor(x, 16); pp[k] = x; }
                if (r32 < 8) { const int j = jb + 8 * kt + 2 * q4 + hh; IMPm[tokl * 64 + j] = pp[0] + pp[1] + pp[2] + 0.5f * pp[3]; if (j + 1 < 64) IMPs[tokl * 64 + j + 1] = 0.5f * pp[3]; } }
    }
}

__device__ __forceinline__ void attn_tile2(const bf16* Kt_, const bf16* Vt_, const bf16x8 (&qf)[4], f32x16 (&o)[2], float& m, float& l, int t, float slope2, int pos0, int maskmode, bool lane_sel, int r32, int hh) {
    f32x16 s[2]; s[0] = f32x16{}; s[1] = f32x16{};
#pragma unroll
    for (int st = 0; st < 4; ++st) { s[0] = mfma32(ld8(Kt_ + r32 * 72 + 16 * st + 8 * hh), qf[st], s[0]); s[1] = mfma32(ld8(Kt_ + (32 + r32) * 72 + 16 * st + 8 * hh), qf[st], s[1]); }
    const float C1 = 0.125f * LOG2E;
    const int dbi = t - pos0 - 4 * hh;
    const float b0 = lane_sel ? (-slope2 * (float)dbi - m) : -1.0e30f;
#pragma unroll
    for (int kt = 0; kt < 2; ++kt)
#pragma unroll
        for (int i = 0; i < 16; ++i) { const int cst = 32 * kt + (i & 3) + 8 * (i >> 2); s[kt][i] = fmaf(s[kt][i], C1, fmaf(slope2, (float)cst, b0)); }
    if (maskmode == 1) {
#pragma unroll
        for (int kt = 0; kt < 2; ++kt)
#pragma unroll
            for (int i = 0; i < 16; ++i) { const int cst = 32 * kt + (i & 3) + 8 * (i >> 2); s[kt][i] = (cst <= dbi) ? s[kt][i] : -1.0e30f; }
    } else if (maskmode == 2) {
#pragma unroll
        for (int kt = 0; kt < 2; ++kt)
#pragma unroll
            for (int i = 0; i < 16; ++i) { const int cst = 32 * kt + (i & 3) + 8 * (i >> 2); s[kt][i] = (dbi - cst < 512) ? s[kt][i] : -1.0e30f; }
    }
    float mx = -1.0e30f;
#pragma unroll
    for (int i = 0; i < 16; ++i) mx = fmaxf(mx, fmaxf(s[0][i], s[1][i]));
    mx = fmaxf(mx, __shfl_xor(mx, 32));
    if (__any(mx > 0.f)) {
        const float dl = fmaxf(mx, 0.f), alpha = __builtin_amdgcn_exp2f(-dl); m += dl; l *= alpha;
#pragma unroll
        for (int i = 0; i < 16; ++i) { o[0][i] *= alpha; o[1][i] *= alpha; s[0][i] -= dl; s[1][i] -= dl; }
    }
    float ps = 0.f;
#pragma unroll
    for (int kt = 0; kt < 2; ++kt)
#pragma unroll
        for (int i = 0; i < 16; ++i) { const float p = __builtin_amdgcn_exp2f(s[kt][i]); s[kt][i] = p; ps += p; }
    l += ps;
#pragma unroll
    for (int kt = 0; kt < 2; ++kt)
#pragma unroll
        for (int s2 = 0; s2 < 2; ++s2) { const bf16x8 pb = pack8(s[kt], s2);
            const bf16* vb_ = Vt_ + (32 * kt + 16 * s2 + 4 * hh + ((r32 & 15) >> 2)) * 32 + 16 * (r32 >> 4) + 4 * (r32 & 3);
            o[0] = mfma32(ldtr8(vb_), pb, o[0]);
            o[1] = mfma32(ldtr8(vb_ + 2048), pb, o[1]); }
}

__device__ __forceinline__ void attn_unit(const Params& P, unsigned char* lds, int l, int uid, int tid) {
    asm volatile("" : "+v"(tid));
    const int qt = uid >> 3, b = (uid >> 1) & 3, g = uid & 1, cur = qt;
    const int wave = tid >> 6, lane = tid & 63, r32 = lane & 31, hh = lane >> 5, tl = r32 & 7, r = r32 >> 3, tokl = 8 * wave + tl, t = 64 * qt + tokl, hd = 4 * g + r;
    const float slope2 = __builtin_amdgcn_exp2f(-(float)(hd + 1)) * LOG2E;
    bf16* KsC = (bf16*)(lds + AL_KSC); bf16* Ks = (bf16*)(lds + AL_KS); bf16* Vt = (bf16*)(lds + AL_VT);
    float* IMPm = (float*)(lds + AL_IMPM); float* IMPs = (float*)(lds + AL_IMPS); unsigned char* selb = lds + AL_SELB;
    const bf16* PROJ = (const bf16*)(P.ws + WS_PROJ); const float* GATES = (const float*)(P.ws + WS_GATES);
    const bf16* KCk = (const bf16*)(P.ws + WS_KC) + (size_t)((0 * 4 + b) * 2 + g) * 256 * 64; const bf16* KCv = (const bf16*)(P.ws + WS_KC) + (size_t)((1 * 4 + b) * 2 + g) * 256 * 64;
    const int lrow = tid >> 3, lch = tid & 7;
    for (int i = tid; i < 8192; i += NTHR) IMPm[i] = 0.f;
    bf16x8 qf[4];
    { const bf16* qrow = PROJ + (size_t)(b * SEQ + t) * PLD + C_QN + hd * 64 + 8 * hh;
#pragma unroll
        for (int st = 0; st < 4; ++st) qf[st] = ld8(qrow + 16 * st); }
    const float* grow = GATES + (size_t)(b * SEQ + t) * 32 + g * 12 + r * 3;
    const float gate_c = sigmoidf_(grow[0]), gate_s = sigmoidf_(grow[1]), gate_w = sigmoidf_(grow[2]);
    f32x16 outacc[2]; outacc[0] = f32x16{}; outacc[1] = f32x16{};
    f32x16 o[2];
    const int ntile = (4 * qt + 3 + 63) >> 6;
    for (int tile = 0; tile < ntile; ++tile) *(u32x4*)(KsC + tile * 4608 + lrow * 72 + lch * 8) = *(const u32x4*)(KCk + (size_t)(tile * 64 + lrow) * 64 + lch * 8);
    u32x4 vreg = *(const u32x4*)(KCv + (size_t)lrow * 64 + lch * 8), kreg = {0u, 0u, 0u, 0u};
#define VT_WRITE(buf, reg) (*(u32x4*)(Vt + (buf) * 4096 + (lch >> 2) * 2048 + lrow * 32 + (lch & 3) * 8) = (reg))
#define KS_WRITE(buf, reg) (*(u32x4*)(Ks + (buf) * 4608 + lrow * 72 + lch * 8) = (reg))
    VT_WRITE(0, vreg);
    __syncthreads();
    float m_c = -1.0e30f, l_c = 0.f;
    for (int tile = 0; tile < ntile; ++tile) attn_tile<0>(KsC + tile * 4608, nullptr, qf, o, m_c, l_c, 0.f, t, slope2, 1024 * tile + 31, 16, true, IMPm, IMPs, tokl, 16 * tile, r32, hh);
    { const float lt = l_c + __shfl_xor(l_c, 32); const float invl = lt > 0.f ? 1.0f / lt : 0.f;
        o[0] = f32x16{}; o[1] = f32x16{};
        for (int tile = 0; tile < ntile; ++tile) {
            if (tile + 1 < ntile) vreg = *(const u32x4*)(KCv + (size_t)((tile + 1) * 64 + lrow) * 64 + lch * 8);
            attn_tile<1>(KsC + tile * 4608, Vt + (tile & 1) * 4096, qf, o, m_c, l_c, invl, t, slope2, 1024 * tile + 31, 16, true, IMPm, IMPs, tokl, 16 * tile, r32, hh);
            if (tile + 1 < ntile) VT_WRITE((tile + 1) & 1, vreg);
            __syncthreads();
        }
#pragma unroll
        for (int i = 0; i < 16; ++i) { outacc[0][i] = gate_c * o[0][i]; outacc[1][i] = gate_c * o[1][i]; }
    }
    {
        const int tok = tid >> 3, sub = tid & 7; float vv[8];
#pragma unroll
        for (int k = 0; k < 8; ++k) { const int j = sub * 8 + k; float v = IMPm[tok * 64 + j] + IMPs[tok * 64 + j];
            if (j == 0 || j == cur || j == cur - 1) v += 1.0e4f;
            if (j > cur) v = -1.0f;
            vv[k] = v; }
#pragma unroll
        for (int k = 0; k < 8; ++k) IMPm[tok * 64 + sub * 8 + k] = vv[k];
        __syncthreads();
        unsigned bits = 0u;
#pragma unroll
        for (int k = 0; k < 8; ++k) { const int j = sub * 8 + k; int rank = 0;
#pragma unroll 4
            for (int j2 = 0; j2 < 64; ++j2) { const float x = IMPm[tok * 64 + j2]; rank += (x > vv[k] || (x == vv[k] && j2 < j)) ? 1 : 0; }
            if (rank < 16 && j <= cur) bits |= 1u << k; }
        selb[tok * 8 + sub] = (unsigned char)bits;
        __syncthreads();
    }
    const unsigned sel_lo = *(const unsigned*)(selb + tokl * 8), sel_hi = *(const unsigned*)(selb + tokl * 8 + 4);
    unsigned long long uni;
    { unsigned ulo = *(const unsigned*)(selb + lane * 8), uhi = *(const unsigned*)(selb + lane * 8 + 4);
#pragma unroll
        for (int of = 1; of < 64; of <<= 1) { ulo |= __shfl_xor(ulo, of); uhi |= __shfl_xor(uhi, of); }
        uni = ((unsigned long long)(unsigned)__builtin_amdgcn_readfirstlane(uhi) << 32) | (unsigned)__builtin_amdgcn_readfirstlane(ulo); }
    {
        unsigned long long it_uni = uni; int it_wj = cur; const int jlo = cur - 8 < 0 ? 0 : cur - 8;
#define TNEXT(dst) do { if (it_uni) { const int j_ = 63 - __builtin_clzll(it_uni); it_uni &= ~(1ull << j_); dst = j_; } else if (it_wj >= jlo) { dst = 256 + it_wj; --it_wj; } else dst = -1; } while (0)
#define TLOAD(kr, vr, code) do { const int br_ = (code) >> 8, j_ = (code) & 255; const bf16* rp_ = PROJ + (size_t)(b * SEQ + 64 * j_ + lrow) * PLD + C_KV + (2 + 2 * br_) * 128 + g * 64 + lch * 8; \
        kr = *(const u32x4*)rp_; vr = *(const u32x4*)(rp_ + 128); } while (0)
        float m_r = 0.f, l_r = 0.f; o[0] = f32x16{}; o[1] = f32x16{}; bool in_win = false;
#define TCOMPUTE(buf, code) do { const int br_ = (code) >> 8, j_ = (code) & 255; \
        if (br_ && !in_win) { in_win = true; const float lt_ = l_r + __shfl_xor(l_r, 32); const float sc_ = lt_ > 0.f ? gate_s / lt_ : 0.f; \
            _Pragma("unroll") for (int i = 0; i < 16; ++i) { outacc[0][i] += sc_ * o[0][i]; outacc[1][i] += sc_ * o[1][i]; } \
            m_r = 0.f; l_r = 0.f; o[0] = f32x16{}; o[1] = f32x16{}; } \
        if (br_) attn_tile2(Ks + (buf) * 4608, Vt + (buf) * 4096, qf, o, m_r, l_r, t, slope2, 64 * j_, (j_ == cur) ? 1 : ((j_ == cur - 8) ? 2 : 0), true, r32, hh); \
        else { const bool lsel_ = (j_ < 32 ? (sel_lo >> j_) : (sel_hi >> (j_ - 32))) & 1u; \
            if (__any(lsel_)) attn_tile2(Ks + (buf) * 4608, Vt + (buf) * 4096, qf, o, m_r, l_r, t, slope2, 64 * j_, (j_ == cur) ? 1 : 0, lsel_, r32, hh); } } while (0)
        const u32x4 z4 = {0u, 0u, 0u, 0u};
        u32x4 kA0, vA0, kA1 = z4, vA1 = z4, kB0 = z4, vB0 = z4, kB1 = z4, vB1 = z4;
        int c0, c1, n0, n1, nn0, nn1, t0_, t1_;
#define TLOAD2(k0, v0, k1, v1, a, b_) do { if ((a) >= 0) TLOAD(k0, v0, a); if ((b_) >= 0) TLOAD(k1, v1, b_); } while (0)
#define TWRITE2(st, k0, v0, k1, v1, a, b_) do { if ((a) >= 0) { KS_WRITE(2 * (st), k0); VT_WRITE(2 * (st), v0); } if ((b_) >= 0) { KS_WRITE(2 * (st) + 1, k1); VT_WRITE(2 * (st) + 1, v1); } } while (0)
        TNEXT(c0); TNEXT(c1); TNEXT(n0); TNEXT(n1);
        TLOAD2(kA0, vA0, kA1, vA1, c0, c1); TLOAD2(kB0, vB0, kB1, vB1, n0, n1);
        TWRITE2(0, kA0, vA0, kA1, vA1, c0, c1);
        __syncthreads();
        TNEXT(nn0); TNEXT(nn1); TLOAD2(kA0, vA0, kA1, vA1, nn0, nn1);
        for (;;) {
            TCOMPUTE(0, c0); if (c1 >= 0) TCOMPUTE(1, c1);
            TWRITE2(1, kB0, vB0, kB1, vB1, n0, n1);
            __syncthreads();
            if (n0 < 0) break;
            TNEXT(t0_); TNEXT(t1_); TLOAD2(kB0, vB0, kB1, vB1, t0_, t1_);
            c0 = n0; c1 = n1; n0 = nn0; n1 = nn1; nn0 = t0_; nn1 = t1_;
            TCOMPUTE(2, c0); if (c1 >= 0) TCOMPUTE(3, c1);
            TWRITE2(0, kA0, vA0, kA1, vA1, n0, n1);
            __syncthreads();
            if (n0 < 0) break;
            TNEXT(t0_); TNEXT(t1_); TLOAD2(kA0, vA0, kA1, vA1, t0_, t1_);
            c0 = n0; c1 = n1; n0 = nn0; n1 = nn1; nn0 = t0_; nn1 = t1_;
        }
#undef TLOAD2
#undef TWRITE2
        { const float lt = l_r + __shfl_xor(l_r, 32); const float sc = lt > 0.f ? gate_w / lt : 0.f;
#pragma unroll
            for (int i = 0; i < 16; ++i) { outacc[0][i] += sc * o[0][i]; outacc[1][i] += sc * o[1][i]; } }
#undef TNEXT
#undef TLOAD
#undef TCOMPUTE
    }
#undef VT_WRITE
#undef KS_WRITE
    bf16* Y = (bf16*)(P.ws + WS_Y) + (size_t)(b * SEQ + t) * DM + hd * 64;
#pragma unroll
    for (int db = 0; db < 2; ++db)
#pragma unroll
        for (int q4 = 0; q4 < 4; ++q4) { u32x2 w; w.x = pk2(outacc[db][4 * q4], outacc[db][4 * q4 + 1]); w.y = pk2(outacc[db][4 * q4 + 2], outacc[db][4 * q4 + 3]);
            *(u32x2*)(Y + 32 * db + 8 * q4 + 4 * hh) = w; }
}

#ifndef EXP_DUP
#define EXP_DUP -1
#endif
constexpr int N_PHASES = 21;
constexpr int MGU_A = MGU_P + 2624, MGU_B = MGU_A + 2560;
__global__ void __launch_bounds__(NTHR, 2) hybrid_fwd(Params P) {
    extern __shared__ __attribute__((aligned(16))) unsigned char lds[];
    cg::grid_group grid = cg::this_grid();
    const int G = gridDim.x, bx0 = blockIdx.x, NGW = G * NWAVES;
    const int wave0 = __builtin_amdgcn_readfirstlane((int)threadIdx.x >> 6);
#define IDS() int lane_; asm volatile("v_mbcnt_lo_u32_b32 %0, -1, 0\n\tv_mbcnt_hi_u32_b32 %0, -1, %0" : "=v"(lane_)); int wave_ = wave0, bx_ = bx0; asm volatile("" : "+s"(wave_), "+s"(bx_)); const int wave = wave_, bx = bx_, lane = lane_, tid = wave * 64 + lane, gw = bx * NWAVES + wave; (void)gw
    unsigned char* ws = P.ws;
    PG8_LAS unsigned char* glds = (PG8_LAS unsigned char*)lds;
#ifndef ONLY_KIND
#define ONLY_KIND -1
#endif
#ifndef ONLY_MASK
#define ONLY_MASK 0
#endif
#define KIND(x) ((ONLY_KIND < 0 && ONLY_MASK == 0) || ONLY_KIND == (x) || ((ONLY_MASK >> (x)) & 1))
#ifndef EXP_DUP
#define EXP_DUP -1
#endif
#define REPS(x) for (int rep_ = 0, nrep_ = ((EXP_DUP == (x)) ? 2 : 1); rep_ < nrep_; ++rep_)
#define RUN(k) (P.ph_lo <= (k) && (k) < P.ph_hi)
    if (threadIdx.x < 2) ((volatile LAS unsigned*)((LAS unsigned char*)lds + LDS_BAR_ST))[threadIdx.x] = 0u;
    __syncthreads();
    XcdBarrier xbar = xcd_barrier_post((unsigned*)(ws + WS_CTL) + CW_BAR + P.li * XCD_BAR_WORDS, (volatile LAS unsigned*)((LAS unsigned char*)lds + LDS_BAR_ST));
    if (P.ph_lo < 0) grid.sync();
#define SEAM(k) do { if (RUN(k) && RUN((k) + 1)) xcd_barrier(xbar); } while (0)
    if (RUN(0) && KIND(0)) { IDS(); REPS(0) prologue(P, lds, gw, NGW, wave, lane); }
    SEAM(0);
    for (int l = 0; l < 2; ++l) {
        const int pb = 1 + 9 * l;
        const float* xin = (l == 0) ? P.in[0] : P.out;
        if (RUN(pb + 0) && KIND(1)) { IDS(); REPS(1) rowpass<false>(P, lds, xin, P.in[4] + l * DM, l, 0, 1024, bx, G, tid, wave, lane); mod_finalize(P, l, bx, tid); }
        SEAM(pb + 0);
        if (RUN(pb + 1) && KIND(2)) { IDS();
            pg8::Gemm g{(const pg8::bf16_t*)(ws + WS_XN), (const pg8::bf16_t*)(ws + WS_WIN) + (size_t)l * NPROJ * DM, M, NPROJ, DM, 0, DM};
            pg8::StaticOrder S; S.init(M, NPROJ, G, bx);
            EpiProj E{(bf16*)(ws + WS_PROJ), (float*)(ws + WS_GATES), (const float*)(ws + WS_BIASP) + l * NPROJ};
            REPS(2) pg8::gemm_phase<EpiProj, pg8::StaticOrder, true, true>(glds, g, S, E, tid);
            if (G == 256 && bx >= 128) conv_moe_gu_items(P, (bf16*)(lds + wave * 16384), l == 0 ? MGU_P : MGU_B, l == 0 ? MGU_A : MGU_ITEMS, (bx - 128) * NWAVES + wave, 128 * NWAVES, lane);
            else if (G != 256 && l == 0) conv_moe_gu_items(P, (bf16*)(lds + wave * 16384), MGU_P, MGU_ITEMS, gw, NGW, lane);
        }
        SEAM(pb + 1);
        if (RUN(pb + 2)) { IDS();
            bf16* dscr = (bf16*)(lds + LDS_DCONV + wave * 9216);
            if (KIND(3)) REPS(3) for (int u = bx; u < 256; u += G) { CItem it = {nullptr, nullptr, 0, 0, 0}; f32x4 cv[16]; const bool hv = (l == 0) && ditem_decode(P, u * 8 + wave, lane, it); if (hv) conv_issue(it, cv); else conv_zero(cv);
                compress_unit(P, lds, l, u, tid); if (hv) conv_finish(it, cv, dscr, lane); }
            if (KIND(4)) REPS(4) for (int u = bx; u < 1024; u += G) { CItem it = {nullptr, nullptr, 0, 0, 0}; f32x4 cv[16]; const bool hv = (l == 0) && ditem_decode(P, 2048 + u * 8 + wave, lane, it); if (hv) conv_issue(it, cv); else conv_zero(cv);
                mlstm_local_unit(P, lds, l, u, tid); if (hv) conv_finish(it, cv, dscr, lane); }
        }
        SEAM(pb + 2);
        if (RUN(pb + 3)) { IDS();
            if (KIND(5)) REPS(5) mlstm_scan(P, bx, G, tid, wave, lane);
            if (KIND(6)) REPS(6) for (int u0 = bx; u0 < 256; u0 += G) { attn_unit(P, lds, l, u0, tid); attn_unit(P, lds, l, 511 - u0, tid); }
        }
        SEAM(pb + 3);
        if (RUN(pb + 4) && KIND(7)) { IDS(); REPS(7) for (int uu = gw; uu < 2048; uu += NGW) mlstm_out_wave(P, lds + wave * 16384, (float*)(lds + 131072 + 512 + wave * 1024), l, uu, lane); __syncthreads(); }
        SEAM(pb + 4);
        if (RUN(pb + 5) && KIND(8)) { IDS();
            pg8::Gemm g{(const pg8::bf16_t*)(ws + WS_Y), (const pg8::bf16_t*)(ws + WS_WOUT) + (size_t)l * DM * DM, M, DM, DM, 0, DM};
            pg8::StaticOrder S; S.init(M, DM, G, bx);
            REPS(8) { EpiRes E{xin, (rep_ + 1 < nrep_) ? (float*)(ws + WS_XG) : P.out, (const float*)(ws + WS_MODF), l, 2048};
            pg8::gemm_phase<EpiRes, pg8::StaticOrder, true, true>(glds, g, S, E, tid); }
        }
        SEAM(pb + 5);
        if (RUN(pb + 6) && KIND(9)) { IDS(); if (l == 0) rowpass<false>(P, lds, P.out, P.in[5], 0, 3072, 4096, bx, G, tid, wave, lane); else rowpass<true>(P, lds, P.out, P.in[5] + DM, 1, 3072, 4096, bx, G, tid, wave, lane); }
        SEAM(pb + 6);
        if (l == 0) {
            if (RUN(pb + 7) && KIND(10)) { IDS();
                pg8::Gemm g{(const pg8::bf16_t*)(ws + WS_XN), (const pg8::bf16_t*)(ws + WS_WGU), M, 2 * DFF, DM, 0, DM};
                pg8::StaticOrder S; S.init(M, 2 * DFF, G, bx);
                EpiSwiglu E{(bf16*)(ws + WS_HB), DFF};
                REPS(10) pg8::gemm_phase<EpiSwiglu, pg8::StaticOrder, true, true>(glds, g, S, E, tid);
                if (G == 256 && bx >= 128) conv_moe_gu_items(P, (bf16*)(lds + wave * 16384), MGU_A, MGU_B, (bx - 128) * NWAVES + wave, 128 * NWAVES, lane);
            }
            SEAM(pb + 7);
            if (RUN(pb + 8) && KIND(11)) { IDS();
                pg8::Gemm g{(const pg8::bf16_t*)(ws + WS_HB), (const pg8::bf16_t*)(ws + WS_WDN), M, DM, DFF, 0, DFF};
                pg8::StaticOrder S; S.init(M, DM, G, bx);
                REPS(11) { EpiRes E{P.out, (rep_ + 1 < nrep_) ? (float*)(ws + WS_XG) : P.out, (const float*)(ws + WS_MODF), 0, 5120};
                pg8::gemm_phase<EpiRes, pg8::StaticOrder, true, true>(glds, g, S, E, tid); }
            }
            SEAM(pb + 8);
        } else {
            if (RUN(pb + 7) && KIND(12)) { IDS(); moe_scatter(P, lds, bx, G, tid, wave, lane); conv_moe_dn_items(P, (bf16*)(lds + wave * 16384), gw, NGW, lane); }
            SEAM(pb + 7);
            if (RUN(pb + 8) && KIND(13)) { IDS();
                pg8::Gemm g{(const pg8::bf16_t*)(ws + WS_XG), (const pg8::bf16_t*)(ws + WS_MOE_GU), MAXR, 2 * DFFE, DM, (size_t)2 * DFFE * DM * 2, DM};
                MoeOrder S; S.init((const unsigned*)(ws + WS_CTL) + CW_CNT, 28, G, bx);
                EpiSwiglu E{(bf16*)(ws + WS_HG), DFFE};
                REPS(13) pg8::gemm_phase<EpiSwiglu, MoeOrder, true, true>(glds, g, S, E, tid);
            }
            SEAM(pb + 8);
            if (RUN(pb + 9) && KIND(14)) { IDS();
                MoeOrder S; S.init((const unsigned*)(ws + WS_CTL) + CW_CNT, 4, G, bx);
                const int total = S.total(), full = (total / G) * G, rest = total - full; const bool splitk = rest > 0 && rest <= 32;
                S.hi = splitk ? full : total;
                {   pg8::Gemm g{(const pg8::bf16_t*)(ws + WS_HG), (const pg8::bf16_t*)(ws + WS_MOE_DN), MAXR, DM, DFFE, (size_t)DM * DFFE * 2, DFFE};
                    EpiF32 E{(float*)(ws + WS_YG)};
                    REPS(14) pg8::gemm_phase<EpiF32, MoeOrder, true, true>(glds, g, S, E, tid); }
                if (splitk) {
                    MoeOrderT<4> S2; S2.init((const unsigned*)(ws + WS_CTL) + CW_CNT, 4, G, bx); S2.lo = full; S2.hi = total; S2.kpart = DFFE / 4;
                    pg8::Gemm g{(const pg8::bf16_t*)(ws + WS_HG), (const pg8::bf16_t*)(ws + WS_MOE_DN), MAXR, DM, DFFE / 4, (size_t)DM * DFFE * 2, DFFE};
                    EpiPart E{(float*)(ws + WS_PART)};
                    int lane2; asm volatile("v_mbcnt_lo_u32_b32 %0, -1, 0\n\tv_mbcnt_hi_u32_b32 %0, -1, %0" : "=v"(lane2));
                    pg8::gemm_phase<EpiPart, MoeOrderT<4>, true, true>(glds, g, S2, E, wave * 64 + lane2);
                    xcd_barrier(xbar);
                    int lane3; asm volatile("v_mbcnt_lo_u32_b32 %0, -1, 0\n\tv_mbcnt_hi_u32_b32 %0, -1, %0" : "=v"(lane3)); const int tid3 = wave * 64 + lane3;
                    const float* PART = (const float*)(ws + WS_PART); float* YG = (float*)(ws + WS_YG);
                    for (int idx = bx * NTHR + tid3; idx < rest * 16384; idx += G * NTHR) {
                        const int r = idx >> 14, w = idx & 16383, row = w >> 6, c4 = (w & 63) * 4;
                        pg8::Unit uu; MoeOrder S3 = S; S3.lo = full + r; S3.hi = full + r + 1; S3.c = 0; S3.next(0, uu);
                        const float* pp = PART + (size_t)(r * 4) * 65536 + row * 256 + c4;
                        const f32x4 v = (*(const f32x4*)pp + *(const f32x4*)(pp + 65536)) + (*(const f32x4*)(pp + 2 * 65536) + *(const f32x4*)(pp + 3 * 65536));
                        *(f32x4*)(YG + (size_t)(uu.pm * 256 + row) * DM + uu.pn * 256 + c4) = v; }
                }
            }
            SEAM(pb + 9);
        }
    }
    if (RUN(20) && KIND(15)) { IDS(); moe_combine_final(P, lds, bx, G, tid, wave, lane); }
#undef RUN
#undef SEAM
}

extern "C" void kernel_launch(void* const* d_in, const int* in_sizes, int n_in, void* d_out, int out_size, void* d_ws, size_t ws_size, hipStream_t stream) {
    static int grid = 0;
    if (grid == 0) {
        if (n_in != 23 || out_size != M * DM || ws_size < WS_END) { fprintf(stderr, "kernel_launch: unexpected shapes (n_in %d out %d ws %zu, need %zu)\n", n_in, out_size, ws_size, (size_t)WS_END); grid = -1; return; }
        int dev = 0, cus = 0, per_cu = 0;
        hipGetDevice(&dev); hipDeviceGetAttribute(&cus, hipDeviceAttributeMultiprocessorCount, dev);
        hipFuncSetAttribute((const void*)hybrid_fwd, hipFuncAttributeMaxDynamicSharedMemorySize, LDS_BYTES);
        if (hipOccupancyMaxActiveBlocksPerMultiprocessor(&per_cu, (const void*)hybrid_fwd, NTHR, LDS_BYTES) != hipSuccess || per_cu < 1) { fprintf(stderr, "kernel_launch: occupancy query says %d\n", per_cu); per_cu = 1; }
        (void)hipGetLastError();
        grid = cus;
        if (grid <= 0) grid = 256;
    }
    if (grid < 0) return;
    hipMemsetAsync((char*)d_ws + WS_CTL, 0, CTL_ZERO_BYTES, stream);
    Params p{};
    for (int i = 0; i < 23; ++i) p.in[i] = (const float*)d_in[i];
    p.out = (float*)d_out; p.ws = (unsigned char*)d_ws;
#if MK_PER_PHASE
    for (int ph = 0; ph < N_PHASES; ++ph) { p.ph_lo = ph; p.ph_hi = ph + 1; void* args[] = {&p};
        hipError_t e = hipLaunchCooperativeKernel((const void*)hybrid_fwd, dim3(grid), dim3(NTHR), args, LDS_BYTES, stream);
        if (e != hipSuccess) { fprintf(stderr, "cooperative launch (phase %d) failed: %s\n", ph, hipGetErrorString(e)); break; } }
#elif defined(PROBE_PHASE)
    for (int li = 0; li < 2; ++li) { p.li = li; p.ph_lo = li == 0 ? 0 : PROBE_PHASE; p.ph_hi = li == 0 ? PROBE_PHASE + 1 : N_PHASES; void* args[] = {&p};
        hipError_t e = hipLaunchCooperativeKernel((const void*)hybrid_fwd, dim3(grid), dim3(NTHR), args, LDS_BYTES, stream);
        if (e != hipSuccess) { fprintf(stderr, "cooperative launch failed: %s\n", hipGetErrorString(e)); break; } }
#else
    p.ph_lo = 0; p.ph_hi = N_PHASES; void* args[] = {&p};
    hipError_t e = hipLaunchCooperativeKernel((const void*)hybrid_fwd, dim3(grid), dim3(NTHR), args, LDS_BYTES, stream);
    if (e != hipSuccess) fprintf(stderr, "cooperative launch failed: %s (grid %d)\n", hipGetErrorString(e), grid);
#endif
}
```

```cpp
#include <hip/hip_runtime.h>
#include <hip/hip_cooperative_groups.h>
#include <cstdio>
#include <cstdint>
namespace cg = cooperative_groups;
namespace pg8 {
#define PG8_LAS __attribute__((address_space(3)))
typedef unsigned short bf16_t;
typedef short bf16x8 __attribute__((ext_vector_type(8)));
typedef float f32x4 __attribute__((ext_vector_type(4)));
typedef unsigned u32x4 __attribute__((ext_vector_type(4)));
constexpr int BM = 256, BK = 64, HALF = 128, HTB = HALF * BK * 2  , STAGE_BYTES = 8 * HTB, NXCD = 8, WGM = 8;

__host__ __device__ __forceinline__ int lds_byte(int r, int c) { const int st = (r >> 4) * 2 + (c >> 5), rr = r & 15, cc = c & 31, ob = rr * 64 + cc * 2; return st * 1024 + (ob ^ (((ob >> 9) & 1) << 5)); }
__host__ __device__ __forceinline__ void stage_rc(int b, int& R, int& C) { const int st = b / 1024, sb = b % 1024, swz = sb ^ (((sb >> 9) & 1) << 5); R = (st >> 1) * 16 + swz / 64; C = (st & 1) * 32 + (swz % 64) / 2; }
__host__ __device__ __forceinline__ int perm32(int rho) { const int n = rho >> 4, i = rho & 15; return 8 * (i >> 2) + 4 * n + (i & 3); }

struct Unit { int pm, pn, e, koff, aux; };
struct Gemm { const bf16_t* A; const bf16_t* Bt; int M, N, K; size_t estride; int ld; };
struct StaticOrder {
    int nM, nN, nwg, G, c;
    __host__ __device__ void init(int M, int N, int G_, int c_) { nM = M / BM; nN = N / BM; nwg = nM * nN; G = G_; c = c_; }
    __host__ __device__ bool next(int i, Unit& u) const {
        const long L = (long)i * G + c; if (L >= nwg) return false;
        int wgid = (int)L; { const int q = nwg / NXCD, r = nwg % NXCD, xcd = wgid % NXCD, off = wgid / NXCD; wgid = (xcd < r ? xcd * (q + 1) : r * (q + 1) + (xcd - r) * q) + off; }
        const int nig = WGM * nN, gid = wgid / nig, fm = gid * WGM, gsz = (nM - fm) < WGM ? (nM - fm) : WGM;
        u.pm = fm + ((wgid % nig) % gsz); u.pn = (wgid % nig) / gsz; u.e = 0; u.koff = 0; u.aux = 0; return true;
    }
    __device__ __forceinline__ void a_ready(const Unit&) const {}
    __device__ __forceinline__ void done(const Unit&) const {}
};

__device__ __forceinline__ unsigned cvt_pk_bf16(float lo, float hi) { unsigned r; asm volatile("v_cvt_pk_bf16_f32 %0, %1, %2" : "=v"(r) : "v"(lo), "v"(hi)); return r; }
typedef float f32x2 __attribute__((ext_vector_type(2)));
template <class Epi, class Sched, bool ALIGN_EPI = false, bool SP2 = false>
__device__ __forceinline__ void gemm_phase(PG8_LAS unsigned char* lds, const Gemm g, const Sched& S, const Epi& E, int tid_) {
        const int tid = tid_, wid = __builtin_amdgcn_readfirstlane(tid >> 6), lane = tid & 63, wr = wid >> 2, wc = wid & 3, fr = lane & 15, fq = lane >> 4;
    const int K = g.K, nt = K / BK;
    unsigned voffA[2], voffB[2];
#pragma unroll
    for (int i = 0; i < 2; ++i) { int R, C; stage_rc(tid * 16 + i * 8192, R, C); const int Rb = Epi::PERM ? ((R & ~31) + perm32(R & 31)) : R;
        voffA[i] = (unsigned)(R * g.ld + C) * 2u; voffB[i] = (unsigned)(Rb * g.ld + C) * 2u; }
    const size_t kstep = (size_t)(BK * 2);
    const size_t hstep = (size_t)HALF * g.ld * 2;
    const size_t tstep = 2 * hstep;
    const unsigned ldsw = (unsigned)wid * 1024u;
    const int aoff = lds_byte(wr * 64 + fr, fq * 8), boff = lds_byte(wc * 32 + fr, fq * 8);
#define PG8_SA(b, h) (((b) * 2 + (h)) * HTB)
#define PG8_SB(b, h) ((4 + (b) * 2 + (h)) * HTB)
#define PG8_STAGE(bufoff, gbase, voff) do { _Pragma("unroll") for (int _i = 0; _i < 2; ++_i) \
        __builtin_amdgcn_global_load_lds((const unsigned*)((const char*)(gbase) + (voff)[_i]), (PG8_LAS unsigned*)(lds + (bufoff) + ldsw + _i * 8192), 16, 0, 0); } while (0)
#define PG8_LDA(dst, b, h) do { _Pragma("unroll") for (int m = 0; m < 4; ++m) _Pragma("unroll") for (int k = 0; k < 2; ++k) dst[m][k] = *(const PG8_LAS bf16x8*)(lds + PG8_SA(b, h) + aoff + m * 2048 + k * 1024); } while (0)
#define PG8_LDB(dst, b, h) do { _Pragma("unroll") for (int n = 0; n < 2; ++n) _Pragma("unroll") for (int k = 0; k < 2; ++k) dst[n][k] = *(const PG8_LAS bf16x8*)(lds + PG8_SB(b, h) + boff + n * 2048 + k * 1024); } while (0)
#define PG8_MMA(ai, bj, At, Bt) do { __builtin_amdgcn_s_setprio(1); _Pragma("unroll") for (int m = 0; m < 4; ++m) _Pragma("unroll") for (int n = 0; n < 2; ++n) _Pragma("unroll") for (int k = 0; k < 2; ++k) \
        acc[ai][bj][m][n] = __builtin_amdgcn_mfma_f32_16x16x32_bf16(Bt[n][k], At[m][k], acc[ai][bj][m][n], 0, 0, 0); __builtin_amdgcn_s_setprio(0); } while (0)
#define PG8_WAIT_V(n) asm volatile("s_waitcnt vmcnt(" #n ")" ::: "memory")
#define PG8_WAIT_L(n) asm volatile("s_waitcnt lgkmcnt(" #n ")" ::: "memory")
#define PG8_BAR __builtin_amdgcn_s_barrier()
#define PG8_SCHED __builtin_amdgcn_sched_barrier(0)
    Unit cur, nxt; int ui = 0;
    if (!S.next(0, cur)) return;
    f32x4 acc[2][2][4][2];
#pragma unroll
    for (int a = 0; a < 2; ++a)
#pragma unroll
        for (int b = 0; b < 2; ++b)
#pragma unroll
            for (int m = 0; m < 4; ++m)
#pragma unroll
                for (int n = 0; n < 2; ++n) acc[a][b][m][n] = (f32x4){0.f, 0.f, 0.f, 0.f};
    bf16x8 At[4][2], B0[2][2], B1[2][2];
    const char* cA = (const char*)g.A + (size_t)cur.pm * tstep + (size_t)cur.koff * 2; const char* cB = (const char*)g.Bt + (size_t)cur.pn * tstep + (size_t)cur.e * g.estride + (size_t)cur.koff * 2;
    S.a_ready(cur);
    if constexpr (SP2) {
        PG8_STAGE(PG8_SB(0, 0), cB, voffB); PG8_STAGE(PG8_SB(0, 1), cB + hstep, voffB); PG8_STAGE(PG8_SA(0, 0), cA, voffA); PG8_STAGE(PG8_SA(0, 1), cA + hstep, voffA);
        if (wr == 1) PG8_BAR;
        PG8_WAIT_V(2); PG8_BAR;
        PG8_STAGE(PG8_SB(1, 0), cB + kstep, voffB); PG8_STAGE(PG8_SA(1, 0), cA + kstep, voffA); PG8_STAGE(PG8_SB(1, 1), cB + hstep + kstep, voffB);
        PG8_WAIT_V(6); PG8_BAR;
    } else {
        PG8_STAGE(PG8_SB(0, 0), cB, voffB); PG8_STAGE(PG8_SA(0, 0), cA, voffA); PG8_STAGE(PG8_SB(0, 1), cB + hstep, voffB); PG8_STAGE(PG8_SA(0, 1), cA + hstep, voffA);
        if (wr == 1) PG8_BAR;
        PG8_WAIT_V(4); PG8_BAR;
        PG8_STAGE(PG8_SB(1, 0), cB + kstep, voffB); PG8_STAGE(PG8_SA(1, 0), cA + kstep, voffA); PG8_STAGE(PG8_SB(1, 1), cB + hstep + kstep, voffB);
        PG8_WAIT_V(6); PG8_BAR;
    }
    for (;;) {
        const bool has_next = S.next(ui + 1, nxt);
        const char* nA = has_next ? (const char*)g.A + (size_t)nxt.pm * tstep + (size_t)nxt.koff * 2 : cA; const char* nB = has_next ? (const char*)g.Bt + (size_t)nxt.pn * tstep + (size_t)nxt.e * g.estride + (size_t)nxt.koff * 2 : cB;
        for (int t = 0; t < nt; t += 2) {
            const bool last = (t == nt - 2);
            const char* a1 = cA + (size_t)(t + 1) * kstep;
            const char* a2 = last ? nA : cA + (size_t)(t + 2) * kstep; const char* b2 = last ? nB : cB + (size_t)(t + 2) * kstep;
            const char* a3 = a2 + kstep; const char* b3 = b2 + kstep;
            if (last && has_next) S.a_ready(nxt);
            if constexpr (SP2) {
            PG8_LDB(B0, 0, 0); PG8_LDB(B1, 0, 1); PG8_SCHED; PG8_LDA(At, 0, 0); PG8_STAGE(PG8_SA(1, 1), a1 + hstep, voffA);
            PG8_WAIT_V(8); PG8_WAIT_L(0); PG8_BAR; PG8_MMA(0, 0, At, B0); PG8_MMA(0, 1, At, B1); PG8_BAR; PG8_SCHED;
            PG8_LDA(At, 0, 1); PG8_STAGE(PG8_SB(0, 0), b2, voffB); PG8_STAGE(PG8_SB(0, 1), b2 + hstep, voffB); PG8_STAGE(PG8_SA(0, 0), a2, voffA);
            PG8_WAIT_V(8); PG8_WAIT_L(0); PG8_BAR; PG8_MMA(1, 0, At, B0); PG8_MMA(1, 1, At, B1); PG8_BAR; PG8_SCHED;
            PG8_LDB(B0, 1, 0); PG8_LDB(B1, 1, 1); PG8_SCHED; PG8_LDA(At, 1, 0); PG8_STAGE(PG8_SA(0, 1), a2 + hstep, voffA);
            PG8_WAIT_V(8); PG8_WAIT_L(0); PG8_BAR; PG8_MMA(0, 0, At, B0); PG8_MMA(0, 1, At, B1); PG8_BAR; PG8_SCHED;
            PG8_LDA(At, 1, 1); PG8_STAGE(PG8_SB(1, 0), b3, voffB); PG8_STAGE(PG8_SB(1, 1), b3 + hstep, voffB); PG8_STAGE(PG8_SA(1, 0), a3, voffA);
            PG8_WAIT_V(8); PG8_WAIT_L(0); PG8_BAR; PG8_MMA(1, 0, At, B0); PG8_MMA(1, 1, At, B1); PG8_BAR; PG8_SCHED;
            } else {
            PG8_LDB(B0, 0, 0); PG8_SCHED; PG8_LDA(At, 0, 0); PG8_STAGE(PG8_SA(1, 1), a1 + hstep, voffA);
            PG8_WAIT_L(8); PG8_BAR; PG8_WAIT_L(0); PG8_MMA(0, 0, At, B0); PG8_BAR; PG8_SCHED;
            PG8_LDB(B1, 0, 1); PG8_STAGE(PG8_SB(0, 0), b2, voffB);
            PG8_BAR; PG8_WAIT_L(0); PG8_MMA(0, 1, At, B1); PG8_BAR;
            PG8_LDA(At, 0, 1); PG8_STAGE(PG8_SA(0, 0), a2, voffA);
            PG8_BAR; PG8_WAIT_L(0); PG8_MMA(1, 0, At, B0); PG8_BAR; PG8_SCHED;
            PG8_STAGE(PG8_SB(0, 1), b2 + hstep, voffB);
            PG8_WAIT_V(6); PG8_BAR; PG8_MMA(1, 1, At, B1); PG8_BAR;
            PG8_LDB(B0, 1, 0); PG8_SCHED; PG8_LDA(At, 1, 0); PG8_STAGE(PG8_SA(0, 1), a2 + hstep, voffA);
            PG8_WAIT_L(8); PG8_BAR; PG8_WAIT_L(0); PG8_MMA(0, 0, At, B0); PG8_BAR; PG8_SCHED;
            PG8_LDB(B1, 1, 1); PG8_STAGE(PG8_SB(1, 0), b3, voffB);
            PG8_BAR; PG8_WAIT_L(0); PG8_MMA(0, 1, At, B1); PG8_BAR;
            PG8_LDA(At, 1, 1); PG8_STAGE(PG8_SA(1, 0), a3, voffA);
            PG8_BAR; PG8_WAIT_L(0); PG8_MMA(1, 0, At, B0); PG8_BAR; PG8_SCHED;
            PG8_STAGE(PG8_SB(1, 1), b3 + hstep, voffB);
            PG8_WAIT_V(6); PG8_BAR; PG8_MMA(1, 1, At, B1); PG8_BAR;
            }
        }
        if constexpr (ALIGN_EPI) { if (wr == 0) PG8_BAR; }
        if constexpr (!Epi::AFTER_DRAIN) { E(acc, cur, wr, wc, fr, fq); S.done(cur); }
        if (!has_next) break;
#pragma unroll
        for (int a = 0; a < 2; ++a)
#pragma unroll
            for (int b = 0; b < 2; ++b)
#pragma unroll
                for (int m = 0; m < 4; ++m)
#pragma unroll
                    for (int n = 0; n < 2; ++n) acc[a][b][m][n] = (f32x4){0.f, 0.f, 0.f, 0.f};
        cur = nxt; cA = nA; cB = nB; ++ui;
        if constexpr (ALIGN_EPI) { if (wr == 1) PG8_BAR; }
    }
    PG8_WAIT_V(0);
    if constexpr (!ALIGN_EPI) { if (wr == 0) PG8_BAR; }
    PG8_BAR;
    if constexpr (Epi::AFTER_DRAIN) { E.fused(acc, cur, wr, wc, fr, fq, lds, wid, lane); S.done(cur); }
#undef PG8_SA
#undef PG8_SB
#undef PG8_STAGE
#undef PG8_LDA
#undef PG8_LDB
#undef PG8_MMA
#undef PG8_WAIT_V
#undef PG8_WAIT_L
#undef PG8_BAR
#undef PG8_SCHED
}
}

#ifndef MK_PER_PHASE
#define MK_PER_PHASE 0
#endif
typedef unsigned short bf16;
typedef float f32x4 __attribute__((ext_vector_type(4)));
typedef float f32x16 __attribute__((ext_vector_type(16)));
typedef short bf16x8 __attribute__((ext_vector_type(8)));
typedef unsigned u32x4 __attribute__((ext_vector_type(4)));
typedef unsigned u32x2 __attribute__((ext_vector_type(2)));

constexpr int NB = 4, SEQ = 4096, DM = 1024, M = NB * SEQ;
constexpr int NPROJ = 3584, PLD = 3328;
constexpr int C_QN = 0, C_KV = 512, C_QKM = 1280, C_VM = 2304, C_OM = 2816;
constexpr int IN_COLS = 3360;
constexpr int DFF = 2816, DFFE = 3584, NE = 8, MAXR = 34816;
constexpr int NWAVES = 8, NTHR = 512;
constexpr float EPSN = 1e-6f;
constexpr float LOG2E = 1.4426950408889634f;

constexpr size_t MiB = 1u << 20;
constexpr size_t WS_CTL = 0, CTL_ZERO_BYTES = 64 * 1024;
constexpr size_t WS_MODP = 1 * MiB;
constexpr size_t WS_C1P = WS_MODP + 1572864;
constexpr size_t WS_BIASP = WS_C1P + 32768;
constexpr size_t WS_TOPI = 3 * MiB;
constexpr size_t WS_TOPW = WS_TOPI + 131072;
constexpr size_t WS_DEST = WS_TOPW + 131072;
constexpr size_t WS_RWT = WS_DEST + 131072 + 65536;
constexpr size_t WS_MODF = WS_DEST + 131072 + 65536 + 32768;
constexpr size_t WS_WCNT = WS_DEST + 131072;
constexpr size_t WS_MOE_GU = 4 * MiB;
constexpr size_t WS_YG = WS_MOE_GU;
constexpr size_t WS_XG = 116 * MiB;
constexpr size_t WS_ARENA = 184 * MiB;
constexpr size_t WS_HG = WS_ARENA;
constexpr size_t WS_XN = WS_ARENA;
constexpr size_t WS_PROJ = WS_ARENA + 32 * MiB;
constexpr size_t WS_HB = WS_PROJ;
constexpr size_t WS_GATES = WS_ARENA + 136 * MiB;
constexpr size_t WS_KC = WS_ARENA + 138 * MiB;
constexpr size_t WS_NL = WS_KC + 524288;
constexpr size_t WS_SC = WS_ARENA + 139 * MiB;
constexpr size_t WS_MP = WS_SC + 65536;
constexpr size_t WS_LC = WS_ARENA + 140 * MiB;
constexpr size_t WS_CP = WS_ARENA + 204 * MiB;
constexpr size_t WS_NP = WS_ARENA + 236 * MiB;
constexpr size_t WS_Y = WS_ARENA + 237 * MiB;
constexpr size_t WS_WSMALL = WS_ARENA + 269 * MiB;
constexpr size_t WS_WIN = WS_WSMALL;
constexpr size_t WS_WOUT = WS_WIN + 14 * MiB;
constexpr size_t WS_WGU = WS_WOUT + 4 * MiB;
constexpr size_t WS_WDN = WS_WGU + 11 * MiB;
constexpr size_t WS_W1T = WS_WDN + 5767168;
constexpr size_t WS_END = WS_W1T + 2 * MiB;
constexpr size_t WS_MOE_DN = WS_HG + (size_t)MAXR * DFFE * 2;
static_assert(WS_MOE_DN + (size_t)NE * DM * DFFE * 2 <= WS_END, "MOE_DN fits");
static_assert(WS_YG + (size_t)MAXR * DM * 4 <= WS_ARENA, "YG fits");
static_assert(WS_XG + (size_t)MAXR * DM * 2 <= WS_ARENA, "XG fits");
constexpr int CW_CNT = 0, CW_CUR = 64, CW_BAR = 1024;
constexpr int LDS_BAR_ST = 131072;

constexpr int LDS_BYTES = 147456;

struct Params { const float* in[23]; float* out; unsigned char* ws; int ph_lo, ph_hi, li, pad; };

__device__ __forceinline__ float bf2f(unsigned v) { return __uint_as_float(v << 16); }
__device__ __forceinline__ unsigned f2bf(float f) { unsigned u = __float_as_uint(f); return (u + 0x7fffu + ((u >> 16) & 1u)) >> 16; }
typedef float f32x2_t __attribute__((ext_vector_type(2))); typedef __bf16 bf16x2_t __attribute__((ext_vector_type(2)));
__device__ __forceinline__ unsigned pk2(float lo, float hi) { f32x2_t v = {lo, hi}; bf16x2_t b = __builtin_convertvector(v, bf16x2_t); return __builtin_bit_cast(unsigned, b); }
__device__ __forceinline__ float wave_sum(float v) {
#pragma unroll
    for (int o = 1; o < 64; o <<= 1) v += __shfl_xor(v, o);
    return v;
}
__device__ __forceinline__ float wave_max(float v) {
#pragma unroll
    for (int o = 1; o < 64; o <<= 1) v = fmaxf(v, __shfl_xor(v, o));
    return v;
}
__device__ __forceinline__ float sigmoidf_(float x) { return 1.0f / (1.0f + __expf(-x)); }
__device__ __forceinline__ float siluf_(float x) { return x / (1.0f + __expf(-x)); }
__device__ __forceinline__ float logsigmoidf_(float x) { return fminf(x, 0.f) - log1pf(__expf(-fabsf(x))); }
#define LDS_WAIT() asm volatile("s_waitcnt lgkmcnt(0)" ::: "memory")

__device__ __forceinline__ f32x4 ldu4(const float* ubase, unsigned voffb) { return *(const f32x4*)((const char*)ubase + voffb); }
__device__ __forceinline__ f32x4 mod4u(const float* ada_b, const float* MODP, int l, int b, int ucol, unsigned voffb) {
    f32x4 v = ldu4(ada_b + l * 6144 + ucol, voffb);
#pragma unroll
    for (int kc = 0; kc < 8; ++kc) v += ldu4(MODP + (size_t)((l * 8 + kc) * 4 + b) * 6144 + ucol, voffb);
    return v;
}
__device__ __forceinline__ f32x4 mod4(const float* ada_b, const float* MODP, int l, int b, int col) {
    f32x4 v = *(const f32x4*)(ada_b + l * 6144 + col);
#pragma unroll
    for (int kc = 0; kc < 8; ++kc) v += *(const f32x4*)(MODP + (size_t)((l * 8 + kc) * 4 + b) * 6144 + col);
    return v;
}

struct EpiProj {
    static constexpr bool PERM = false, AFTER_DRAIN = false;
    bf16* PROJ; float* GATES; const float* bias;
    __device__ __forceinline__ void operator()(const f32x4 (&acc)[2][2][4][2], const pg8::Unit& u, int wr, int wc, int fr, int fq) const {
        const int row0 = u.pm * 256 + wr * 64 + fr, col0 = u.pn * 256 + wc * 32 + 4 * fq;
        f32x4 bv[2][2];
#pragma unroll
        for (int bj = 0; bj < 2; ++bj)
#pragma unroll
            for (int n = 0; n < 2; ++n) bv[bj][n] = *(const f32x4*)(bias + col0 + bj * 128 + n * 16);
        if (u.pn < 13) {
#pragma unroll
            for (int ai = 0; ai < 2; ++ai)
#pragma unroll
                for (int m = 0; m < 4; ++m) { bf16* rowp = PROJ + (size_t)(row0 + ai * 128 + m * 16) * PLD + col0;
#pragma unroll
                    for (int bj = 0; bj < 2; ++bj)
#pragma unroll
                        for (int n = 0; n < 2; ++n) { const f32x4 v = acc[ai][bj][m][n] + bv[bj][n]; u32x2 w; w.x = pk2(v[0], v[1]); w.y = pk2(v[2], v[3]); *(u32x2*)(rowp + bj * 128 + n * 16) = w; } }
        } else if (wc == 0) {
#pragma unroll
            for (int ai = 0; ai < 2; ++ai)
#pragma unroll
                for (int m = 0; m < 4; ++m) { float* rowp = GATES + (size_t)(row0 + ai * 128 + m * 16) * 32 + 4 * fq;
#pragma unroll
                    for (int n = 0; n < 2; ++n) *(f32x4*)(rowp + n * 16) = acc[ai][0][m][n] + bv[0][n]; }
        }
    }
};
struct EpiRes {
    static constexpr bool PERM = false, AFTER_DRAIN = false;
    const float* xin; float* xout; const float* MODF; int l, goff;
    __device__ __forceinline__ void operator()(const f32x4 (&acc)[2][2][4][2], const pg8::Unit& u, int wr, int wc, int fr, int fq) const {
        const int row0 = u.pm * 256 + wr * 64 + fr, col0 = u.pn * 256 + wc * 32 + 4 * fq, b = (u.pm * 256) >> 12;
        f32x4 gv[2][2];
#pragma unroll
        for (int bj = 0; bj < 2; ++bj)
#pragma unroll
            for (int n = 0; n < 2; ++n) gv[bj][n] = *(const f32x4*)(MODF + (size_t)(l * 4 + b) * 6144 + goff + col0 + bj * 128 + n * 16);
#pragma unroll
        for (int ai = 0; ai < 2; ++ai)
#pragma unroll
            for (int m = 0; m < 4; ++m) { const size_t off = (size_t)(row0 + ai * 128 + m * 16) * DM + col0;
#pragma unroll
                for (int bj = 0; bj < 2; ++bj)
#pragma unroll
                    for (int n = 0; n < 2; ++n) { const f32x4 x = *(const f32x4*)(xin + off + bj * 128 + n * 16); *(f32x4*)(xout + off + bj * 128 + n * 16) = x + gv[bj][n] * acc[ai][bj][m][n]; } }
    }
};
struct EpiSwiglu {
    static constexpr bool PERM = false, AFTER_DRAIN = false;
    bf16* H; int ldh;
    __device__ __forceinline__ void operator()(const f32x4 (&acc)[2][2][4][2], const pg8::Unit& u, int wr, int wc, int fr, int fq) const {
        const int row0 = u.pm * 256 + wr * 64 + fr, hc0 = u.pn * 128 + wc * 32 + 4 * fq;
#pragma unroll
        for (int ai = 0; ai < 2; ++ai)
#pragma unroll
            for (int m = 0; m < 4; ++m) { bf16* rowp = H + (size_t)(row0 + ai * 128 + m * 16) * ldh + hc0;
#pragma unroll
                for (int n = 0; n < 2; ++n) { const f32x4 g = acc[ai][0][m][n], uu = acc[ai][1][m][n]; f32x4 v;
#pragma unroll
                    for (int k = 0; k < 4; ++k) v[k] = siluf_(g[k]) * uu[k];
                    u32x2 w; w.x = pk2(v[0], v[1]); w.y = pk2(v[2], v[3]); *(u32x2*)(rowp + n * 16) = w; } }
    }
};
struct EpiF32 {
    static constexpr bool PERM = false, AFTER_DRAIN = false;
    float* O;
    __device__ __forceinline__ void operator()(const f32x4 (&acc)[2][2][4][2], const pg8::Unit& u, int wr, int wc, int fr, int fq) const {
        const int row0 = u.pm * 256 + wr * 64 + fr, col0 = u.pn * 256 + wc * 32 + 4 * fq;
#pragma unroll
        for (int ai = 0; ai < 2; ++ai)
#pragma unroll
            for (int m = 0; m < 4; ++m) { const size_t off = (size_t)(row0 + ai * 128 + m * 16) * DM + col0;
#pragma unroll
                for (int bj = 0; bj < 2; ++bj)
#pragma unroll
                    for (int n = 0; n < 2; ++n) *(f32x4*)(O + off + bj * 128 + n * 16) = acc[ai][bj][m][n]; }
    }
};
template <int SPLIT> struct MoeOrderT {
    int cum[9]; int nN, G, c, lo, hi, kpart;
    __device__ __forceinline__ void init(const unsigned* cnt, int nN_, int G_, int c_) { nN = nN_; G = G_; c = c_; cum[0] = 0; kpart = 0;
#pragma unroll
        for (int e = 0; e < 8; ++e) cum[e + 1] = cum[e] + (int)((cnt[e] + 255u) >> 8);
        lo = 0; hi = cum[8] * nN; }
    __device__ __forceinline__ int total() const { return cum[8] * nN; }
    __device__ __forceinline__ bool next(int i, pg8::Unit& u) const {
        const int q = i * G + c; if (q >= (hi - lo) * SPLIT) return false;
        const int L = lo + q / SPLIT, ks = q % SPLIT;
        int se = 0, sb = 0, st = 1;
#pragma unroll
        for (int e = 0; e < 8; ++e) { if (L >= cum[e] * nN && L < cum[e + 1] * nN) { se = e; sb = cum[e]; st = cum[e + 1] - cum[e]; } }
        const int local = L - sb * nN; u.pm = sb + local % st; u.pn = local / st; u.e = se; u.koff = ks * kpart; u.aux = q; return true;
    }
    __device__ __forceinline__ void a_ready(const pg8::Unit&) const {}
    __device__ __forceinline__ void done(const pg8::Unit&) const {}
};
typedef MoeOrderT<1> MoeOrder;
struct EpiPart {
    static constexpr bool PERM = false, AFTER_DRAIN = false;
    float* PART;
    __device__ __forceinline__ void operator()(const f32x4 (&acc)[2][2][4][2], const pg8::Unit& u, int wr, int wc, int fr, int fq) const {
        float* base = PART + (size_t)u.aux * 65536 + (size_t)(wr * 64 + fr) * 256 + wc * 32 + 4 * fq;
#pragma unroll
        for (int ai = 0; ai < 2; ++ai)
#pragma unroll
            for (int m = 0; m < 4; ++m)
#pragma unroll
                for (int bj = 0; bj < 2; ++bj)
#pragma unroll
                    for (int n = 0; n < 2; ++n) *(f32x4*)(base + (size_t)(ai * 128 + m * 16) * 256 + bj * 128 + n * 16) = acc[ai][bj][m][n];
    }
};
constexpr size_t WS_PART = 140 * MiB;
static_assert(WS_YG + (size_t)MAXR * DM * 4 <= WS_PART && WS_PART + (size_t)128 * 65536 * 4 <= WS_ARENA, "PART fits");

__device__ __forceinline__ void conv_item64(const float* W, int ldw, int scol, int k0, bf16* dst, int dpitch, bf16* scr, int lane) {
    const int kq = lane >> 4, n4 = lane & 15;
    f32x4 v[16];
    const float* src = W + (size_t)(k0 + kq) * ldw + (scol >= 0 ? scol : 0);
#pragma unroll
    for (int i = 0; i < 16; ++i) v[i] = *(const f32x4*)(src + (size_t)(4 * i) * ldw);
    if (scol < 0) {
#pragma unroll
        for (int i = 0; i < 16; ++i) v[i] = (f32x4){0.f, 0.f, 0.f, 0.f}; }
#pragma unroll
    for (int i = 0; i < 16; ++i) { const int k = 4 * i + kq; const unsigned p0 = pk2(v[i][0], v[i][1]), p1 = pk2(v[i][2], v[i][3]); bf16* d = scr + (4 * n4) * 72 + k;
        d[0] = (bf16)(p0 & 0xffffu); d[72] = (bf16)(p0 >> 16); d[144] = (bf16)(p1 & 0xffffu); d[216] = (bf16)(p1 >> 16); }
    LDS_WAIT();
    const int c = lane & 7;
#pragma unroll
    for (int j = 0; j < 8; ++j) { const int n = (lane >> 3) + 8 * j; const u32x4 o = *(const u32x4*)(scr + n * 72 + 8 * c); *(u32x4*)(dst + (size_t)n * dpitch + 8 * c) = o; }
    LDS_WAIT();
}
__device__ __forceinline__ int proj_src_col(int n) { return n < 1280 ? n : (n < 3328 ? n + 24 : (n < 3352 ? n - 2048 : (n < 3360 ? n : -1))); }

struct CItem { const float* src; bf16* dst; int ldw, dpitch, zero; };
__device__ __forceinline__ void conv_issue(const CItem& it, f32x4 (&v)[16]) {
#pragma unroll
    for (int i = 0; i < 16; ++i) v[i] = *(const f32x4*)(it.src + (size_t)(4 * i) * it.ldw);
}
__device__ __forceinline__ void conv_zero(f32x4 (&v)[16]) {
#pragma unroll
    for (int i = 0; i < 16; ++i) v[i] = (f32x4){0.f, 0.f, 0.f, 0.f};
}
__device__ __forceinline__ void conv_finish(const CItem& it, f32x4 (&v)[16], bf16* scr, int lane) {
    const int kq = lane >> 4, n4 = lane & 15;
    if (it.zero) {
#pragma unroll
        for (int i = 0; i < 16; ++i) v[i] = (f32x4){0.f, 0.f, 0.f, 0.f}; }
#pragma unroll
    for (int i = 0; i < 16; ++i) { const int k = 4 * i + kq; const unsigned p0 = pk2(v[i][0], v[i][1]), p1 = pk2(v[i][2], v[i][3]); bf16* d = scr + (4 * n4) * 72 + k;
        d[0] = (bf16)(p0 & 0xffffu); d[72] = (bf16)(p0 >> 16); d[144] = (bf16)(p1 & 0xffffu); d[216] = (bf16)(p1 >> 16); }
    LDS_WAIT();
    const int c = lane & 7;
#pragma unroll
    for (int j = 0; j < 8; ++j) { const int n = (lane >> 3) + 8 * j; const u32x4 o = *(const u32x4*)(scr + n * 72 + 8 * c); *(u32x4*)(it.dst + (size_t)n * it.dpitch + 8 * c) = o; }
    LDS_WAIT();
}
__device__ __forceinline__ void citem_make(CItem& it, const float* W, int ldw, int scol, int k0, bf16* dst, int dpitch, int lane) {
    it.src = W + (size_t)(k0 + (lane >> 4)) * ldw + (scol >= 0 ? scol : 0); it.dst = dst; it.ldw = ldw; it.dpitch = dpitch; it.zero = scol < 0;
}
constexpr int MGU_P = 6592;
constexpr int D_WOUT0 = 256, D_WGU = 1408, D_WDN = 704, D_WOUT1 = 256, D_WIN1 = 896, D_W1T1 = 128, D_TOTAL = D_WOUT0 + D_WGU + D_WDN + D_WOUT1 + D_WIN1 + D_W1T1 + MGU_P;
__device__ __forceinline__ bool ditem_decode(const Params& P, int d, int lane, CItem& it) {
    if (d < 0 || d >= D_TOTAL) return false;
    unsigned char* ws = P.ws; const int n4 = 4 * (lane & 15); int r = d;
    if (r < D_WOUT0) { const int kb = r / 16, nb = r % 16; citem_make(it, P.in[14], DM, nb * 64 + n4, kb * 64, (bf16*)(ws + WS_WOUT) + (size_t)(nb * 64) * DM + kb * 64, DM, lane); return true; }
    r -= D_WOUT0;
    if (r < D_WGU) { const int kb = r / 88, nb = r % 88, n0 = nb * 64, t = n0 >> 8, w = n0 & 255; const float* src = (w < 128) ? P.in[15] : P.in[16];
        citem_make(it, src, DFF, t * 128 + (w & 127) + n4, kb * 64, (bf16*)(ws + WS_WGU) + (size_t)n0 * DM + kb * 64, DM, lane); return true; }
    r -= D_WGU;
    if (r < D_WDN) { const int kb = r / 16, nb = r % 16; citem_make(it, P.in[17], DM, nb * 64 + n4, kb * 64, (bf16*)(ws + WS_WDN) + (size_t)(nb * 64) * DFF + kb * 64, DFF, lane); return true; }
    r -= D_WDN;
    if (r < D_WOUT1) { const int kb = r / 16, nb = r % 16; citem_make(it, P.in[14] + (size_t)DM * DM, DM, nb * 64 + n4, kb * 64, (bf16*)(ws + WS_WOUT) + ((size_t)DM + nb * 64) * DM + kb * 64, DM, lane); return true; }
    r -= D_WOUT1;
    if (r < D_WIN1) { const int kb = r / 56, nb = r % 56; citem_make(it, P.in[6] + (size_t)DM * IN_COLS, IN_COLS, proj_src_col(nb * 64 + n4), kb * 64, (bf16*)(ws + WS_WIN) + ((size_t)NPROJ + nb * 64) * DM + kb * 64, DM, lane); return true; }
    r -= D_WIN1;
    if (r < D_W1T1) { const int lj = 2 + r / 64, q = r % 64, kb = q / 2, nb = q % 2; citem_make(it, P.in[9] + (size_t)lj * 2048 * 128, 128, nb * 64 + n4, kb * 64, (bf16*)(ws + WS_W1T) + ((size_t)lj * 128 + nb * 64) * 2048 + kb * 64, 2048, lane); return true; }
    r -= D_W1T1;
    { const int e = r / 1792, q = r % 1792, kb = q / 112, nb = q % 112, n0 = nb * 64, t = n0 >> 8, w = n0 & 255; const float* src = ((w < 128) ? P.in[19] : P.in[20]) + (size_t)e * DM * DFFE;
        citem_make(it, src, DFFE, t * 128 + (w & 127) + n4, kb * 64, (bf16*)(ws + WS_MOE_GU) + ((size_t)e * 7168 + n0) * DM + kb * 64, DM, lane); return true; }
}
constexpr int LDS_DCONV = 57344;

__device__ __forceinline__ void conv_moe_dn_items(const Params& P, bf16* scr, int gw, int NGW, int lane) {
    bf16* dstb = (bf16*)(P.ws + WS_MOE_DN);
    constexpr int NBLK = 16, KBLK = 56, PER_E = NBLK * KBLK;
    for (int it = gw; it < NE * PER_E; it += NGW) { const int e = it / PER_E, r = it % PER_E, kb = r / NBLK, nb = r % NBLK;
        conv_item64(P.in[21] + (size_t)e * DFFE * DM, DM, nb * 64 + 4 * (lane & 15), kb * 64, dstb + ((size_t)e * DM + nb * 64) * DFFE + kb * 64, DFFE, scr, lane); }
}

__device__ __forceinline__ void prologue(const Params& P, unsigned char* lds, int gw, int NGW, int wave, int lane) {
    bf16* scr = (bf16*)(lds + wave * 16384);
    unsigned char* ws = P.ws;
    constexpr int I_WIN = 56 * 16, I_W1T = 2 * 2 * 32;
    constexpr int I_MOD = 2 * 24 * 8, I_C1 = 2 * 2 * 16 * 2, I_BIAS = 112 + 16;
    constexpr int NIT = I_WIN + I_W1T + I_MOD + I_C1 + I_BIAS;
    const int n4 = 4 * (lane & 15);
    for (int it = gw; it < NIT; it += NGW) {
        int r = it;
        if (r < I_MOD) {
            const int l = r / 192, cb = (r % 192) / 8, kc = r % 8, col = cb * 256 + 4 * lane;
            const float* aw = P.in[2] + (size_t)l * DM * 6144; const float* c = P.in[1];
            f32x4 a0 = {0, 0, 0, 0}, a1 = a0, a2 = a0, a3 = a0;
#pragma unroll 8
            for (int k = kc * 128; k < kc * 128 + 128; ++k) { const f32x4 w = *(const f32x4*)(aw + (size_t)k * 6144 + col);
                a0 += siluf_(c[k]) * w; a1 += siluf_(c[DM + k]) * w; a2 += siluf_(c[2 * DM + k]) * w; a3 += siluf_(c[3 * DM + k]) * w; }
            float* o = (float*)(ws + WS_MODP) + (size_t)((l * 8 + kc) * 4) * 6144 + col;
            *(f32x4*)(o) = a0; *(f32x4*)(o + 6144) = a1; *(f32x4*)(o + 2 * 6144) = a2; *(f32x4*)(o + 3 * 6144) = a3;
            continue; }
        r -= I_MOD;
        if (r < I_C1) {
            const int lj = r / 32, kc = (r % 32) / 2, hh = r % 2, hid = hh * 64 + lane;
            const float* pe = P.in[8] + (size_t)lj * 2048; const float* w1 = P.in[9] + (size_t)lj * 2048 * 128;
            float a = 0.f;
#pragma unroll 8
            for (int k = kc * 128; k < kc * 128 + 128; ++k) a += pe[k] * w1[(size_t)k * 128 + hid];
            ((float*)(ws + WS_C1P))[(lj * 16 + kc) * 128 + hid] = a;
            continue; }
        r -= I_C1;
        if (r < I_BIAS) {
            if (r >= 112) { const int col = (r - 112) * 64 + lane; const float* rw = P.in[18] + (size_t)col * 8; float* o = (float*)(ws + WS_RWT) + col;
#pragma unroll
                for (int e = 0; e < 8; ++e) o[e * 1024] = rw[e];
                continue; }
            const int l = r / 56, n = (r % 56) * 64 + lane, s = proj_src_col(n);
            ((float*)(ws + WS_BIASP))[l * NPROJ + n] = s >= 0 ? P.in[7][l * IN_COLS + s] : 0.f;
            continue; }
        r -= I_BIAS;
        if (r < I_WIN) { const int kb = r / 56, nb = r % 56;
            conv_item64(P.in[6], IN_COLS, proj_src_col(nb * 64 + n4), kb * 64, (bf16*)(ws + WS_WIN) + (size_t)(nb * 64) * DM + kb * 64, DM, scr, lane); continue; }
        r -= I_WIN;
        { const int lj = r / 64, q = r % 64, kb = q / 2, nb = q % 2;
            conv_item64(P.in[9] + (size_t)lj * 2048 * 128, 128, nb * 64 + n4, kb * 64, (bf16*)(ws + WS_W1T) + ((size_t)lj * 128 + nb * 64) * 2048 + kb * 64, 2048, scr, lane); }
    }
}
constexpr int MGU_ITEMS = 8 * 112 * 16;
__device__ __forceinline__ void conv_moe_gu_items(const Params& P, bf16* scr, int lo, int hi, int widx, int nw, int lane) {
    const int n4 = 4 * (lane & 15);
    for (int r = lo + widx; r < hi; r += nw) { const int e = r / 1792, q = r % 1792, kb = q / 112, nb = q % 112, n0 = nb * 64, t = n0 >> 8, w = n0 & 255;
        const float* src = ((w < 128) ? P.in[19] : P.in[20]) + (size_t)e * DM * DFFE; const int sc0 = t * 128 + (w & 127);
        conv_item64(src, DFFE, sc0 + n4, kb * 64, (bf16*)(P.ws + WS_MOE_GU) + ((size_t)e * 7168 + n0) * DM + kb * 64, DM, scr, lane); }
}

template <int HF> __device__ __forceinline__ void bfly_reduce(float (&pv)[16], int lane) {
    const bool up = (lane & HF) != 0;
#pragma unroll
    for (int i = 0; i < HF; ++i) { const float keep = up ? pv[i + HF] : pv[i], send = up ? pv[i] : pv[i + HF]; pv[i] = keep + __shfl_xor(send, HF); }
    if constexpr (HF > 1) bfly_reduce<HF / 2>(pv, lane);
}
__device__ __forceinline__ void stage_mod2(const float* ada_b, const float* MODP, int l, int b, int offA, int offB, float* dstA, float* dstB, int tid) {
    const int which = tid >> 8, c4 = (tid & 255) * 4, off = (which ? offB : offA) + c4;
    f32x4 p[9]; p[0] = *(const f32x4*)(ada_b + l * 6144 + off);
#pragma unroll
    for (int kc = 0; kc < 8; ++kc) p[kc + 1] = *(const f32x4*)(MODP + (size_t)((l * 8 + kc) * 4 + b) * 6144 + off);
    f32x4 v = p[0];
#pragma unroll
    for (int kc = 0; kc < 8; ++kc) v += p[kc + 1];
    *(f32x4*)((which ? dstB : dstA) + c4) = v;
}
__device__ __forceinline__ void mod_finalize(const Params& P, int l, int bx, int tid) {
    const int idx = bx * NTHR + tid; if (idx >= 6144) return;
    const int b = idx / 1536, c4 = (idx % 1536) * 4; const float* MODP = (const float*)(P.ws + WS_MODP);
    f32x4 p[9]; p[0] = *(const f32x4*)(P.in[3] + l * 6144 + c4);
#pragma unroll
    for (int kc = 0; kc < 8; ++kc) p[kc + 1] = *(const f32x4*)(MODP + (size_t)((l * 8 + kc) * 4 + b) * 6144 + c4);
    f32x4 v = p[0];
#pragma unroll
    for (int kc = 0; kc < 8; ++kc) v += p[kc + 1];
    *(f32x4*)((float*)(P.ws + WS_MODF) + (size_t)(l * 4 + b) * 6144 + c4) = v;
}
template <bool ROUTER>
__device__ __forceinline__ void rowpass(const Params& P, unsigned char* lds, const float* X, const float* gain, int l, int sh_off, int sc_off, int bx, int G, int tid, int wave, int lane) {
    const float* ada_b = P.in[3]; const float* MODP = (const float*)(P.ws + WS_MODP);
    bf16* XN = (bf16*)(P.ws + WS_XN);
    float* mA = (float*)lds; float* mB = mA + 1024;
    for (int wi0 = bx * NWAVES; wi0 < M / 8; wi0 += G * NWAVES) {
        const int wi = wi0 + wave, row0 = wi * 8, b = (wi0 * 8) >> 12;
        __syncthreads();
        stage_mod2(ada_b, MODP, l, b, sc_off, sh_off, mA, mB, tid);
        __syncthreads();
        f32x4 sg[4], sh[4]; const unsigned lob = 16u * (unsigned)lane;
#pragma unroll
        for (int j = 0; j < 4; ++j) { const f32x4 g = ldu4(gain + 256 * j, lob); sg[j] = (*(const f32x4*)(mA + 4 * lane + 256 * j) + 1.0f) * g; sh[j] = *(const f32x4*)(mB + 4 * lane + 256 * j); }
        unsigned hcnt = 0u;
        f32x4 nx[2][4];
#pragma unroll
        for (int r = 0; r < 2; ++r)
#pragma unroll
            for (int j = 0; j < 4; ++j) nx[r][j] = ldu4(X + (size_t)(row0 + r) * DM + 256 * j, lob);
#pragma unroll 1
        for (int grp = 0; grp < 4; ++grp) {
            f32x4 hrow[2][4];
#pragma unroll
            for (int r = 0; r < 2; ++r)
#pragma unroll
                for (int j = 0; j < 4; ++j) hrow[r][j] = nx[r][j];
            if (grp < 3) {
#pragma unroll
                for (int r = 0; r < 2; ++r)
#pragma unroll
                    for (int j = 0; j < 4; ++j) nx[r][j] = ldu4(X + (size_t)(row0 + 2 * grp + 2 + r) * DM + 256 * j, lob); }
#pragma unroll
            for (int r = 0; r < 2; ++r) {
                const int row = row0 + 2 * grp + r;
                float ss = 0.f;
#pragma unroll
                for (int j = 0; j < 4; ++j) { const f32x4 v = hrow[r][j]; ss += (v[0] * v[0] + v[1] * v[1]) + (v[2] * v[2] + v[3] * v[3]); }
                const float rs = rsqrtf(wave_sum(ss) * (1.0f / DM) + EPSN);
#pragma unroll
                for (int j = 0; j < 4; ++j) { const f32x4 v = hrow[r][j] * rs * sg[j] + sh[j]; u32x2 w; w.x = pk2(v[0], v[1]); w.y = pk2(v[2], v[3]);
                    *(u32x2*)((char*)(XN + (size_t)row * DM + 256 * j) + (lob >> 1)) = w; hrow[r][j] = v; }
            }
            if constexpr (ROUTER) {
                const float* rwt = (const float*)(P.ws + WS_RWT);
                float pv[16];
#pragma unroll
                for (int e = 0; e < 8; ++e) { f32x4 w[4];
#pragma unroll
                    for (int j = 0; j < 4; ++j) w[j] = ldu4(rwt + e * 1024 + 256 * j, lob);
#pragma unroll
                    for (int r = 0; r < 2; ++r) { float a = 0.f;
#pragma unroll
                        for (int j = 0; j < 4; ++j) a += (hrow[r][j][0] * w[j][0] + hrow[r][j][1] * w[j][1]) + (hrow[r][j][2] * w[j][2] + hrow[r][j][3] * w[j][3]);
                        pv[r * 8 + e] = a; } }
                bfly_reduce<8>(pv, lane);
                float lg = pv[0]; lg += __shfl_xor(lg, 16); lg += __shfl_xor(lg, 32);
                const int e = lane & 7;
                float v1 = lg; int i1 = e;
#pragma unroll
                for (int of = 1; of < 8; of <<= 1) { const float ov = __shfl_xor(v1, of); const int oi = __shfl_xor(i1, of); if (ov > v1 || (ov == v1 && oi < i1)) { v1 = ov; i1 = oi; } }
                float v2 = (e == i1) ? -3.0e38f : lg; int i2 = e;
#pragma unroll
                for (int of = 1; of < 8; of <<= 1) { const float ov = __shfl_xor(v2, of); const int oi = __shfl_xor(i2, of); if (ov > v2 || (ov == v2 && oi < i2)) { v2 = ov; i2 = oi; } }
                if (lane < 16 && e == 0) { const int row = row0 + 2 * grp + (lane >> 3);
                    const float w1 = 1.0f / (1.0f + __expf(v2 - v1));
                    int* TI = (int*)(P.ws + WS_TOPI); float* TW = (float*)(P.ws + WS_TOPW);
                    TI[row * 2] = i1; TI[row * 2 + 1] = i2; TW[row * 2] = w1; TW[row * 2 + 1] = 1.0f - w1; }
                unsigned c = (i1 == e ? 1u : 0u) + (i2 == e ? 1u : 0u);
                c += __shfl_xor(c, 8);
                hcnt += c;
            }
        }
        if constexpr (ROUTER) { if (lane < 8) ((unsigned*)(P.ws + WS_WCNT))[(size_t)wi * 8 + lane] = hcnt; }
    }
    __syncthreads();
}

__device__ __forceinline__ void moe_scatter(const Params& P, unsigned char* lds, int bx, int G, int tid, int wave, int lane) {
    unsigned* ctl = (unsigned*)(P.ws + WS_CTL); const unsigned* WC = (const unsigned*)(P.ws + WS_WCNT);
    int* sh = (int*)lds;
    const int* TI = (const int*)(P.ws + WS_TOPI); int* DE = (int*)(P.ws + WS_DEST);
    const bf16* XN = (const bf16*)(P.ws + WS_XN); bf16* XG = (bf16*)(P.ws + WS_XG);
    constexpr int NWI = M / 8;
    if (tid < 16) sh[tid] = 0;
    __syncthreads();
    {
        unsigned a = 0; for (int i = tid; i < NWI * 8; i += NTHR) a += WC[i];
        atomicAdd(&sh[tid & 7], (int)a);
    }
    __syncthreads();
    int pstart[8]; { int acc = 0;
#pragma unroll
        for (int e = 0; e < 8; ++e) { pstart[e] = acc; acc += ((sh[e] + 255) >> 8) << 8; } }
    if (bx == 0 && tid < 8) ctl[CW_CNT + tid] = (unsigned)sh[tid];
    for (int wi0 = bx * NWAVES; wi0 < NWI; wi0 += G * NWAVES) {
        __syncthreads();
        if (tid < 8) sh[8 + tid] = 0;
        __syncthreads();
        { unsigned a = 0; for (int i = tid; i < wi0 * 8; i += NTHR) a += WC[i]; atomicAdd(&sh[8 + (tid & 7)], (int)a); }
        __syncthreads();
        const int wi = wi0 + wave;
        int base[8];
#pragma unroll
        for (int e = 0; e < 8; ++e) { int a = pstart[e] + sh[8 + e]; for (int w = wi0; w < wi; ++w) a += (int)WC[w * 8 + e]; base[e] = a; }
        for (int r = 0; r < 8; ++r) { const int row = wi * 8 + r;
            const u32x4 a = *(const u32x4*)(XN + (size_t)row * DM + 8 * lane), b2 = *(const u32x4*)(XN + (size_t)row * DM + 512 + 8 * lane);
#pragma unroll
            for (int k = 0; k < 2; ++k) { const int e = TI[row * 2 + k];
                int dest = 0;
#pragma unroll
                for (int q = 0; q < 8; ++q) { if (e == q) { dest = base[q]; base[q] += 1; } }
                if (lane == 0) DE[row * 2 + k] = dest;
                *(u32x4*)(XG + (size_t)dest * DM + 8 * lane) = a; *(u32x4*)(XG + (size_t)dest * DM + 512 + 8 * lane) = b2; } }
    }
    __syncthreads();
}

__device__ __forceinline__ void moe_combine_final(const Params& P, unsigned char* lds, int bx, int G, int tid, int wave, int lane) {
    const float* ada_b = P.in[3]; const float* MODP = (const float*)(P.ws + WS_MODP); const float* fg = P.in[22];
    const int* DE = (const int*)(P.ws + WS_DEST); const float* TW = (const float*)(P.ws + WS_TOPW); const float* YG = (const float*)(P.ws + WS_YG);
    float* mA = (float*)lds; float* mB = mA + 1024;
    for (int wi0 = bx * NWAVES; wi0 < M / 8; wi0 += G * NWAVES) {
        const int wi = wi0 + wave, row0 = wi * 8, b = (wi0 * 8) >> 12;
        __syncthreads();
        stage_mod2(ada_b, MODP, 1, b, 5120, 5120, mA, mB, tid);
        __syncthreads();
        f32x4 g2[4], g[4];
#pragma unroll
        for (int j = 0; j < 4; ++j) { const int col = 4 * lane + 256 * j; g2[j] = *(const f32x4*)(mA + col); g[j] = *(const f32x4*)(fg + col); }
        for (int r = 0; r < 8; ++r) { const int row = row0 + r; const int d0 = DE[row * 2], d1 = DE[row * 2 + 1]; const float w0 = TW[row * 2], w1 = TW[row * 2 + 1];
            float* xr = P.out + (size_t)row * DM + 4 * lane; f32x4 v[4]; float ss = 0.f;
#pragma unroll
            for (int j = 0; j < 4; ++j) { const f32x4 y0 = *(const f32x4*)(YG + (size_t)d0 * DM + 4 * lane + 256 * j), y1 = *(const f32x4*)(YG + (size_t)d1 * DM + 4 * lane + 256 * j);
                v[j] = *(const f32x4*)(xr + 256 * j) + g2[j] * (w0 * y0 + w1 * y1); ss += (v[j][0] * v[j][0] + v[j][1] * v[j][1]) + (v[j][2] * v[j][2] + v[j][3] * v[j][3]); }
            const float rs = rsqrtf(wave_sum(ss) * (1.0f / DM) + EPSN);
#pragma unroll
            for (int j = 0; j < 4; ++j) *(f32x4*)(xr + 256 * j) = v[j] * rs * g[j]; }
    }
    __syncthreads();
}

#define LAS __attribute__((address_space(3)))
#define XB_TMO      128
#define XB_XCNT(j)  (256  + 64 * (j))
#define XB_XSUB(j)  (1280 + 64 * (j))
#define XB_XGEN(j)  (2304 + 64 * (j))
#define XB_TOP      3328
#define XB_TOPGEN   3392
#define XCD_BAR_WORDS 3456
#define XB_SPIN_CAP (1u << 18)

__device__ __forceinline__ unsigned xb_ld(unsigned* p)              { return __hip_atomic_load(p, __ATOMIC_RELAXED, __HIP_MEMORY_SCOPE_AGENT); }
__device__ __forceinline__ unsigned xb_add(unsigned* p, unsigned v) { return __hip_atomic_fetch_add(p, v, __ATOMIC_RELAXED, __HIP_MEMORY_SCOPE_AGENT); }
__device__ __forceinline__ unsigned xb_xcc_id() { return (unsigned)__builtin_amdgcn_s_getreg((3 << 11) | 20) & 0xFu; }
#define XB_SPIN(cond, bar) do { unsigned _sp = 0; while (cond) { __builtin_amdgcn_s_sleep(1); \
    if ((++_sp & 255u) == 0u) { if (xb_ld(&(bar)[XB_TMO])) break; if (_sp > XB_SPIN_CAP) { atomicAdd(&(bar)[XB_TMO], 1u); break; } } } } while (0)

struct XcdBarrier {
    unsigned* bar; unsigned x;
    volatile LAS unsigned* st;
};

__device__ __forceinline__ XcdBarrier xcd_barrier_post(unsigned* bar, volatile LAS unsigned* st) {
    XcdBarrier b; b.bar = bar; b.x = xb_xcc_id(); b.st = st;
    if (threadIdx.x == 0) (void)xb_add(&bar[XB_XCNT(b.x)], 1u);
    return b;
}
__device__ __forceinline__ void xcd_barrier_complete(unsigned* bar, unsigned x, unsigned& nloc, unsigned& nx) {
    const unsigned G = gridDim.x * gridDim.y * gridDim.z;
    unsigned sum, cnt, mine, sp = 0u;
    for (;;) {
        sum = 0u; cnt = 0u; mine = 0u;
#pragma unroll
        for (unsigned j = 0; j < 16; ++j) { const unsigned c = xb_ld(&bar[XB_XCNT(j)]); sum += c; cnt += (c > 0u) ? 1u : 0u; mine = (j == x) ? c : mine; }
        if (sum == G) break;
        __builtin_amdgcn_s_sleep(1);
        if ((++sp & 255u) == 0u) { if (xb_ld(&bar[XB_TMO])) break; if (sp > XB_SPIN_CAP) { atomicAdd(&bar[XB_TMO], 1u); break; } }
    }
    nloc = mine > 0u ? mine : 1u; nx = cnt > 0u ? cnt : 1u;
}

__device__ __forceinline__ void xcd_barrier(const XcdBarrier& b) {
    asm volatile("s_waitcnt vmcnt(0)" ::: "memory");
    __syncthreads();
    if (threadIdx.x == 0) {
        unsigned* bar = b.bar;
        __builtin_amdgcn_s_waitcnt(0);
        unsigned nloc = b.st[0], nx = b.st[1];
        if (nloc == 0u) { xcd_barrier_complete(bar, b.x, nloc, nx); b.st[0] = nloc; b.st[1] = nx; }
        const unsigned old = xb_add(&bar[XB_XSUB(b.x)], 1u);
        const unsigned gen = old / nloc;
        if (old + 1u == (gen + 1u) * nloc) {
            __builtin_amdgcn_fence(__ATOMIC_RELEASE, "agent");
            asm volatile("s_waitcnt vmcnt(0)" ::: "memory");
            const unsigned og = xb_add(&bar[XB_TOP], 1u);
            const unsigned tg = og / nx;
            if (og + 1u == (tg + 1u) * nx) xb_add(&bar[XB_TOPGEN], 1u);
            else XB_SPIN(xb_ld(&bar[XB_TOPGEN]) == tg, bar);
            __builtin_amdgcn_fence(__ATOMIC_ACQUIRE, "agent");
            xb_add(&bar[XB_XGEN(b.x)], 1u);
            asm volatile("s_waitcnt vmcnt(0)" ::: "memory");
        } else {
            XB_SPIN(xb_ld(&bar[XB_XGEN(b.x)]) == gen, bar);
            __builtin_amdgcn_fence(__ATOMIC_ACQUIRE, "agent");
            asm volatile("s_waitcnt vmcnt(0)" ::: "memory");
        }
    }
    __syncthreads();
}

__device__ __forceinline__ f32x16 mfma32(bf16x8 a, bf16x8 b, f32x16 c) { return __builtin_amdgcn_mfma_f32_32x32x16_bf16(a, b, c, 0, 0, 0); }
__device__ __forceinline__ f32x4 mfma16(bf16x8 a, bf16x8 b, f32x4 c) { return __builtin_amdgcn_mfma_f32_16x16x32_bf16(a, b, c, 0, 0, 0); }
__device__ __forceinline__ int rowmap(int i, int hh) { return (i & 3) + 8 * (i >> 2) + 4 * hh; }
__device__ __forceinline__ bf16x8 ld8(const bf16* p) { return *(const bf16x8*)p; }
__device__ __forceinline__ bf16x8 ld44(const bf16* p) { const u32x2 lo = *(const u32x2*)p, hi = *(const u32x2*)(p + 8); u32x4 v; v.x = lo.x; v.y = lo.y; v.z = hi.x; v.w = hi.y; return __builtin_bit_cast(bf16x8, v); }
typedef short v4i16_t __attribute__((ext_vector_type(4)));
__device__ __forceinline__ bf16x8 ldtr8(const bf16* vb) {
    const v4i16_t lo = __builtin_amdgcn_ds_read_tr16_b64_v4i16((__attribute__((address_space(3))) v4i16_t*)vb);
    const v4i16_t hi = __builtin_amdgcn_ds_read_tr16_b64_v4i16((__attribute__((address_space(3))) v4i16_t*)(vb + 8 * 32));
    return (bf16x8){lo[0], lo[1], lo[2], lo[3], hi[0], hi[1], hi[2], hi[3]};
}
__device__ __forceinline__ bf16x8 pack8(const f32x16& p, int s) {
    u32x4 v; v.x = pk2(p[8 * s], p[8 * s + 1]); v.y = pk2(p[8 * s + 2], p[8 * s + 3]); v.z = pk2(p[8 * s + 4], p[8 * s + 5]); v.w = pk2(p[8 * s + 6], p[8 * s + 7]);
    return __builtin_bit_cast(bf16x8, v);
}
__device__ __forceinline__ float wave_scan_add(float v, int lane) {
#pragma unroll
    for (int o = 1; o < 64; o <<= 1) { const float t = __shfl_up(v, o); if (lane >= o) v += t; }
    return v;
}
__device__ __forceinline__ float wave_scan_max(float v, int lane) {
#pragma unroll
    for (int o = 1; o < 64; o <<= 1) { const float t = __shfl_up(v, o); if (lane >= o) v = fmaxf(v, t); }
    return v;
}

__device__ __forceinline__ void compress_unit(const Params& P, unsigned char* lds, int l, int u, int tid) {
    asm volatile("" : "+v"(tid));
    const int j = u >> 7, b = (u >> 5) & 3, g = (u >> 4) & 1, nb = u & 15, lj = l * 2 + j;
    const int wave = tid >> 6, lane = tid & 63;
    bf16* T = (bf16*)lds;
    float* Hs = (float*)(lds + 272 * 144);
    const bf16* PROJ = (const bf16*)(P.ws + WS_PROJ);
    for (int idx = tid; idx < 272 * 8; idx += NTHR) { const int row = idx >> 3, ch = idx & 7, tok = 256 * nb + row;
        u32x4 v = {0u, 0u, 0u, 0u};
        if (tok < SEQ) v = *(const u32x4*)(PROJ + (size_t)(b * SEQ + tok) * PLD + C_KV + j * 128 + g * 64 + ch * 8);
        *(u32x4*)(T + ((row & 15) * 17 + (row >> 4)) * 72 + ch * 8) = v; }
    __syncthreads();
    {
        f32x4 acc = {0.f, 0.f, 0.f, 0.f};
        const bf16* wrow = (const bf16*)(P.ws + WS_W1T) + ((size_t)lj * 128 + 16 * wave + (lane & 15)) * 2048 + 8 * (lane >> 4);
        const bf16* arow = T + (lane & 15) * 72 + 8 * (lane >> 4);
#pragma unroll 16
        for (int st = 0; st < 64; ++st) { const int p_ = st >> 1; const bf16x8 a = ld8(arow + ((p_ & 15) * 17 + (p_ >> 4)) * 72 + 32 * (st & 1)); const bf16x8 bb = ld8(wrow + 32 * st); acc = mfma16(a, bb, acc); }
        const int hid = 16 * wave + (lane & 15);
        float c1 = 0.f; const float* c1p = (const float*)(P.ws + WS_C1P) + (size_t)lj * 16 * 128 + hid;
#pragma unroll
        for (int kc = 0; kc < 16; ++kc) c1 += c1p[kc * 128];
#pragma unroll
        for (int r = 0; r < 4; ++r) Hs[(4 * (lane >> 4) + r) * 128 + hid] = siluf_(acc[r] + c1);
    }
    __syncthreads();
    {
        const int n = tid >> 5, dd = (tid & 31) * 2; const float* w2 = P.in[10] + (size_t)lj * 128 * 64 + dd; const float* hs = Hs + n * 128;
        float o0 = 0.f, o1 = 0.f;
#pragma unroll 8
        for (int h = 0; h < 128; ++h) { const float x = hs[h]; o0 += x * w2[h * 64]; o1 += x * w2[h * 64 + 1]; }
        const int ng = 16 * nb + n; if (ng == 255) { o0 = 0.f; o1 = 0.f; }
        bf16* KC = (bf16*)(P.ws + WS_KC) + ((size_t)((j * 4 + b) * 2 + g) * 256 + ng) * 64 + dd;
        *(unsigned*)KC = pk2(o0, o1);
    }
    __syncthreads();
}

__device__ __forceinline__ void conv16(const Params& P, int l, int b, int t, int col0, int cch0, float scale, float (&out)[16]) {
    const bf16* PROJ = (const bf16*)(P.ws + WS_PROJ);
    const float* cw = P.in[11] + (size_t)l * 4 * 1024 + cch0; const float* cb = P.in[12] + (size_t)l * 1024 + cch0;
#pragma unroll
    for (int q = 0; q < 4; ++q) { const f32x4 bb = *(const f32x4*)(cb + 4 * q); out[4 * q] = bb[0]; out[4 * q + 1] = bb[1]; out[4 * q + 2] = bb[2]; out[4 * q + 3] = bb[3]; }
#pragma unroll
    for (int i = 0; i < 4; ++i) { const int tt = t - 3 + i;
        if (tt >= 0) { const bf16* xr = PROJ + (size_t)(b * SEQ + tt) * PLD + col0; const u32x4 x0 = *(const u32x4*)xr, x1 = *(const u32x4*)(xr + 8);
            const unsigned xs[8] = {x0.x, x0.y, x0.z, x0.w, x1.x, x1.y, x1.z, x1.w};
#pragma unroll
            for (int q = 0; q < 4; ++q) { const f32x4 w = *(const f32x4*)(cw + i * 1024 + 4 * q);
                out[4 * q] += w[0] * bf2f(xs[2 * q] & 0xffffu); out[4 * q + 1] += w[1] * bf2f(xs[2 * q] >> 16); out[4 * q + 2] += w[2] * bf2f(xs[2 * q + 1] & 0xffffu); out[4 * q + 3] += w[3] * bf2f(xs[2 * q + 1] >> 16); } } }
#pragma unroll
    for (int q = 0; q < 16; ++q) out[q] = siluf_(out[q]) * scale;
}

__device__ __forceinline__ void mlstm_local_unit(const Params& P, unsigned char* lds, int l, int u, int tid) {
    asm volatile("" : "+v"(tid));
    const int bh = u >> 6, c = u & 63, b = bh >> 2, h = bh & 3, wave = tid >> 6, lane = tid & 63, r32 = lane & 31, hh = lane >> 5;
    bf16* Kt = (bf16*)lds;
    bf16* Vt = (bf16*)(lds + 18432);
    float* wS = (float*)(lds + 36864);
    const float* GATES = (const float*)(P.ws + WS_GATES); const bf16* PROJ = (const bf16*)(P.ws + WS_PROJ);
    const int tok0 = 64 * c;
    if (wave == 0) {
        const float* gr = GATES + (size_t)(b * SEQ + tok0 + lane) * 32;
        const float lf = logsigmoidf_(gr[28 + h]), ig = gr[24 + h];
        const float a = wave_scan_add(lf, lane), aL = __shfl(a, 63);
        const float lw = aL - a + ig, ml = wave_max(lw);
        wS[lane] = __expf(lw - ml);
        if (lane == 0) { float* SC = (float*)(P.ws + WS_SC); SC[u * 2] = aL; SC[u * 2 + 1] = ml; }
    }
    __syncthreads();
    {
        const int s = tid >> 3, ch = tid & 7, d0 = 16 * ch; float kv[16];
        conv16(P, l, b, tok0 + s, C_QKM + 512 + h * 128 + d0, 512 + h * 128 + d0, 0.08838834764831845f, kv);
#pragma unroll
        for (int q = 0; q < 16; ++q) Kt[(d0 + q) * 72 + s] = (bf16)f2bf(kv[q]);
        {
            bf16* kq = (bf16*)(P.ws + WS_XN) + (size_t)(b * SEQ + tok0 + s) * DM + h * 128 + d0; u32x4 w0, w1;
            w0.x = pk2(kv[0], kv[1]); w0.y = pk2(kv[2], kv[3]); w0.z = pk2(kv[4], kv[5]); w0.w = pk2(kv[6], kv[7]); w1.x = pk2(kv[8], kv[9]); w1.y = pk2(kv[10], kv[11]); w1.z = pk2(kv[12], kv[13]); w1.w = pk2(kv[14], kv[15]);
            *(u32x4*)(kq + 512) = w0; *(u32x4*)(kq + 520) = w1;
            float qv[16]; conv16(P, l, b, tok0 + s, C_QKM + h * 128 + d0, h * 128 + d0, 1.0f, qv);
            w0.x = pk2(qv[0], qv[1]); w0.y = pk2(qv[2], qv[3]); w0.z = pk2(qv[4], qv[5]); w0.w = pk2(qv[6], qv[7]); w1.x = pk2(qv[8], qv[9]); w1.y = pk2(qv[10], qv[11]); w1.z = pk2(qv[12], qv[13]); w1.w = pk2(qv[14], qv[15]);
            *(u32x4*)(kq) = w0; *(u32x4*)(kq + 8) = w1; }
        const bf16* vr = PROJ + (size_t)(b * SEQ + tok0 + s) * PLD + C_VM + h * 128 + d0; const u32x4 x0 = *(const u32x4*)vr, x1 = *(const u32x4*)(vr + 8);
        const unsigned xs[8] = {x0.x, x0.y, x0.z, x0.w, x1.x, x1.y, x1.z, x1.w}; const float w = wS[s];
#pragma unroll
        for (int q = 0; q < 8; ++q) { Vt[(d0 + 2 * q) * 72 + s] = (bf16)f2bf(bf2f(xs[q] & 0xffffu) * w); Vt[(d0 + 2 * q + 1) * 72 + s] = (bf16)f2bf(bf2f(xs[q] >> 16) * w); }
    }
    __syncthreads();
    {
        const int et = wave >> 1, dt0 = 2 * (wave & 1);
        f32x16 acc0 = {}, acc1 = {};
#pragma unroll
        for (int st = 0; st < 4; ++st) { const bf16x8 a = ld8(Vt + (32 * et + r32) * 72 + 16 * st + 8 * hh);
            acc0 = mfma32(a, ld8(Kt + (32 * dt0 + r32) * 72 + 16 * st + 8 * hh), acc0);
            acc1 = mfma32(a, ld8(Kt + (32 * (dt0 + 1) + r32) * 72 + 16 * st + 8 * hh), acc1); }
        float* LC = (float*)(P.ws + WS_LC) + (size_t)u * 16384;
#pragma unroll
        for (int i = 0; i < 16; ++i) { const int e = 32 * et + rowmap(i, hh); LC[e * 128 + 32 * dt0 + r32] = acc0[i]; LC[e * 128 + 32 * (dt0 + 1) + r32] = acc1[i]; }
    }
    if (tid < 128) { float nl = 0.f;
#pragma unroll 8
        for (int s = 0; s < 64; ++s) nl += wS[s] * bf2f(Kt[tid * 72 + s]);
        ((float*)(P.ws + WS_NL))[u * 128 + tid] = nl; }
    __syncthreads();
}

__device__ __forceinline__ void mlstm_scan(const Params& P, int bx, int G, int tid, int wave, int lane) {
    const float* __restrict__ LC = (const float*)(P.ws + WS_LC); const float* __restrict__ NL = (const float*)(P.ws + WS_NL); const float* __restrict__ SC = (const float*)(P.ws + WS_SC);
    bf16* __restrict__ CP = (bf16*)(P.ws + WS_CP); float* __restrict__ NP = (float*)(P.ws + WS_NP); float* __restrict__ MP = (float*)(P.ws + WS_MP);
    typedef float f32x2s __attribute__((ext_vector_type(2)));
    for (int gt = bx * NTHR + tid; gt < 16 * 8192; gt += G * NTHR) {
        const int bh = gt >> 13, el = (gt & 8191) * 2;
        f32x2s C = {0.f, 0.f}; float m = 0.f;
        for (int c0 = 0; c0 < 64; c0 += 16) {
            f32x2s Lv[16]; float aL[16], ml[16];
#pragma unroll
            for (int k = 0; k < 16; ++k) { const int u = bh * 64 + c0 + k; Lv[k] = *(const f32x2s*)(LC + (size_t)u * 16384 + el); aL[k] = SC[u * 2]; ml[k] = SC[u * 2 + 1]; }
#pragma unroll
            for (int k = 0; k < 16; ++k) { const int u = bh * 64 + c0 + k;
                *(unsigned*)(CP + (size_t)u * 16384 + el) = pk2(C[0], C[1]);
                if (el == 0) MP[u] = m;
                const float mn = fmaxf(aL[k] + m, ml[k]), f1 = __expf(aL[k] + m - mn), f2 = __expf(ml[k] - mn);
                C = f1 * C + f2 * Lv[k]; m = mn; }
        }
    }
    if (wave == 7) {
        for (int gi = bx * 64 + lane; gi < 16 * 128; gi += G * 64) {
            const int bh = gi >> 7, d = gi & 127; float C = 0.f, m = 0.f;
            for (int c0 = 0; c0 < 64; c0 += 16) {
                float Lv[16], aL[16], ml[16];
#pragma unroll
                for (int k = 0; k < 16; ++k) { const int u = bh * 64 + c0 + k; Lv[k] = NL[u * 128 + d]; aL[k] = SC[u * 2]; ml[k] = SC[u * 2 + 1]; }
#pragma unroll
                for (int k = 0; k < 16; ++k) { const int u = bh * 64 + c0 + k;
                    NP[u * 128 + d] = C;
                    const float mn = fmaxf(aL[k] + m, ml[k]);
                    C = __expf(aL[k] + m - mn) * C + __expf(ml[k] - mn) * Lv[k]; m = mn; }
            }
        }
    }
}

__device__ __forceinline__ void mlstm_out_unit(const Params& P, unsigned char* lds, int l, int u, int tid) {
    asm volatile("" : "+v"(tid));
    const int bh = u >> 6, c = u & 63, b = bh >> 2, h = bh & 3, wave = tid >> 6, lane = tid & 63, r32 = lane & 31, hh = lane >> 5;
    bf16* Qs = (bf16*)lds;
    bf16* Ks = (bf16*)(lds + 17408);
    bf16* Vt = (bf16*)(lds + 34816);
    float* aS = (float*)(lds + 53248);
    float* bS = aS + 64;
    float* GS = aS + 128;
    float* nq = aS + 192;
    float* ssq = aS + 256;
    const float* GATES = (const float*)(P.ws + WS_GATES); const bf16* PROJ = (const bf16*)(P.ws + WS_PROJ);
    const int tok0 = 64 * c; const float mprev = ((const float*)(P.ws + WS_MP))[u];
    if (wave == 0) {
        const float* gr = GATES + (size_t)(b * SEQ + tok0 + lane) * 32;
        const float lf = logsigmoidf_(gr[28 + h]), ig = gr[24 + h];
        const float a = wave_scan_add(lf, lane), bb = ig - a, pm = wave_scan_max(bb, lane);
        aS[lane] = a; bS[lane] = bb; GS[lane] = fmaxf(mprev, pm);
    }
    {
        const int s = tid >> 3, ch = tid & 7, d0 = 16 * ch; float qv[16], kv[16];
        conv16(P, l, b, tok0 + s, C_QKM + h * 128 + d0, h * 128 + d0, 1.0f, qv);
        conv16(P, l, b, tok0 + s, C_QKM + 512 + h * 128 + d0, 512 + h * 128 + d0, 0.08838834764831845f, kv);
        u32x4 w0, w1;
        w0.x = pk2(qv[0], qv[1]); w0.y = pk2(qv[2], qv[3]); w0.z = pk2(qv[4], qv[5]); w0.w = pk2(qv[6], qv[7]); w1.x = pk2(qv[8], qv[9]); w1.y = pk2(qv[10], qv[11]); w1.z = pk2(qv[12], qv[13]); w1.w = pk2(qv[14], qv[15]);
        *(u32x4*)(Qs + s * 136 + d0) = w0; *(u32x4*)(Qs + s * 136 + d0 + 8) = w1;
        w0.x = pk2(kv[0], kv[1]); w0.y = pk2(kv[2], kv[3]); w0.z = pk2(kv[4], kv[5]); w0.w = pk2(kv[6], kv[7]); w1.x = pk2(kv[8], kv[9]); w1.y = pk2(kv[10], kv[11]); w1.z = pk2(kv[12], kv[13]); w1.w = pk2(kv[14], kv[15]);
        *(u32x4*)(Ks + s * 136 + d0) = w0; *(u32x4*)(Ks + s * 136 + d0 + 8) = w1;
        const bf16* vr = PROJ + (size_t)(b * SEQ + tok0 + s) * PLD + C_VM + h * 128 + d0; const u32x4 x0 = *(const u32x4*)vr, x1 = *(const u32x4*)(vr + 8);
        const unsigned xs[8] = {x0.x, x0.y, x0.z, x0.w, x1.x, x1.y, x1.z, x1.w};
#pragma unroll
        for (int q = 0; q < 8; ++q) { Vt[(d0 + 2 * q) * 72 + s] = (bf16)(xs[q] & 0xffffu); Vt[(d0 + 2 * q + 1) * 72 + s] = (bf16)(xs[q] >> 16); }
    }
    __syncthreads();
    {
        const int jq = tid >> 3, part = tid & 7; const float* np = (const float*)(P.ws + WS_NP) + (size_t)u * 128 + part * 16; float a = 0.f;
#pragma unroll
        for (int d = 0; d < 16; ++d) a += np[d] * bf2f(Qs[jq * 136 + part * 16 + d]);
        a += __shfl_xor(a, 1); a += __shfl_xor(a, 2); a += __shfl_xor(a, 4);
        if (part == 0) nq[jq] = a;
    }
    __syncthreads();
    const int et = wave >> 1, jt = wave & 1, jl = 32 * jt + r32;
    bf16x8 qf[8];
#pragma unroll
    for (int st = 0; st < 8; ++st) qf[st] = ld8(Qs + jl * 136 + 16 * st + 8 * hh);
    const float Gj = GS[jl], inter = __expf(mprev - Gj);
    f32x16 acc = {};
    {
        const bf16* cp = (const bf16*)(P.ws + WS_CP) + (size_t)u * 16384 + (32 * et + r32) * 128 + 8 * hh;
#pragma unroll
        for (int st = 0; st < 8; ++st) acc = mfma32(ld8(cp + 16 * st), qf[st], acc);
#pragma unroll
        for (int i = 0; i < 16; ++i) acc[i] *= inter;
    }
    float colsum = 0.f;
#pragma unroll
    for (int kt = 0; kt < 2; ++kt) {
        if (kt <= jt) {
            f32x16 sd = {};
#pragma unroll
            for (int st = 0; st < 8; ++st) sd = mfma32(ld8(Ks + (32 * kt + r32) * 136 + 16 * st + 8 * hh), qf[st], sd);
#pragma unroll
            for (int i = 0; i < 16; ++i) { const int s = 32 * kt + rowmap(i, hh); const float dv = (s <= jl) ? __expf(bS[s] - Gj) : 0.f; sd[i] *= dv; colsum += sd[i]; }
#pragma unroll
            for (int s2 = 0; s2 < 2; ++s2) acc = mfma32(ld44(Vt + (32 * et + r32) * 72 + 32 * kt + 16 * s2 + 4 * hh), pack8(sd, s2), acc);
        }
    }
    colsum += __shfl_xor(colsum, 32);
    const float den = inter * nq[jl] + colsum, dn = fmaxf(fabsf(den), __expf(-(aS[jl] + Gj))), rdn = 1.0f / dn;
    const int trow = b * SEQ + tok0 + jl;
    float part = 0.f;
#pragma unroll
    for (int q = 0; q < 4; ++q) { const int e0 = 32 * et + 8 * q + 4 * hh;
        const u32x2 ov = *(const u32x2*)(PROJ + (size_t)trow * PLD + C_OM + h * 128 + e0);
        const float o0 = bf2f(ov.x & 0xffffu), o1 = bf2f(ov.x >> 16), o2 = bf2f(ov.y & 0xffffu), o3 = bf2f(ov.y >> 16);
        acc[4 * q] *= rdn * sigmoidf_(o0); acc[4 * q + 1] *= rdn * sigmoidf_(o1); acc[4 * q + 2] *= rdn * sigmoidf_(o2); acc[4 * q + 3] *= rdn * sigmoidf_(o3);
        part += acc[4 * q] * acc[4 * q] + acc[4 * q + 1] * acc[4 * q + 1] + acc[4 * q + 2] * acc[4 * q + 2] + acc[4 * q + 3] * acc[4 * q + 3]; }
    part += __shfl_xor(part, 32);
    if (hh == 0) ssq[et * 64 + jl] = part;
    __syncthreads();
    const float tot = ssq[jl] + ssq[64 + jl] + ssq[128 + jl] + ssq[192 + jl], rstd = rsqrtf(tot * (1.0f / 128.0f) + EPSN);
    const float* ng = P.in[13] + (size_t)l * 512 + h * 128; bf16* Y = (bf16*)(P.ws + WS_Y) + (size_t)trow * DM + 512 + h * 128;
#pragma unroll
    for (int q = 0; q < 4; ++q) { const int e0 = 32 * et + 8 * q + 4 * hh; const f32x4 gg = *(const f32x4*)(ng + e0);
        u32x2 w; w.x = pk2(acc[4 * q] * rstd * gg[0], acc[4 * q + 1] * rstd * gg[1]); w.y = pk2(acc[4 * q + 2] * rstd * gg[2], acc[4 * q + 3] * rstd * gg[3]);
        *(u32x2*)(Y + e0) = w; }
    __syncthreads();
}

__device__ __forceinline__ int tb_off(int row, int col) { return (col >> 5) * 2048 + row * 32 + (col & 31); }
__device__ __forceinline__ bf16x8 ldtr_nat(const bf16* tile, int cb, int s0, int lane) {
    const bf16* p = tile + cb * 2048 + (s0 + 8 * (lane >> 5) + ((lane & 15) >> 2)) * 32 + 16 * ((lane >> 4) & 1) + 4 * (lane & 3);
    const v4i16_t lo = __builtin_amdgcn_ds_read_tr16_b64_v4i16((__attribute__((address_space(3))) v4i16_t*)p);
    const v4i16_t hi = __builtin_amdgcn_ds_read_tr16_b64_v4i16((__attribute__((address_space(3))) v4i16_t*)(p + 4 * 32));
    return (bf16x8){lo[0], lo[1], lo[2], lo[3], hi[0], hi[1], hi[2], hi[3]};
}
__device__ __forceinline__ void mlstm_local_wave(const Params& P, unsigned char* ldsw, float* wS, int l, int u, int lane) {
    const int bh = u >> 6, c = u & 63, b = bh >> 2, h = bh & 3, r32 = lane & 31, hh = lane >> 5, tok0 = 64 * c;
    bf16* Kt = (bf16*)ldsw; bf16* Vb = (bf16*)(ldsw + 16384);
    const float* GATES = (const float*)(P.ws + WS_GATES); const bf16* PROJ = (const bf16*)(P.ws + WS_PROJ); bf16* KQC = (bf16*)(P.ws + WS_XN);
    {
        const float* gr = GATES + (size_t)(b * SEQ + tok0 + lane) * 32;
        const float lf = logsigmoidf_(gr[28 + h]), ig = gr[24 + h];
        const float a = wave_scan_add(lf, lane), aL = __shfl(a, 63);
        const float lw = aL - a + ig, ml = wave_max(lw);
        wS[lane] = __expf(lw - ml);
        if (lane == 0) { float* SC = (float*)(P.ws + WS_SC); SC[u * 2] = aL; SC[u * 2 + 1] = ml; }
    }
#pragma unroll 1
    for (int it = 0; it < 8; ++it) {
        const int row = it * 8 + (lane >> 3), d0 = 16 * (lane & 7); float kv[16];
        bf16* kq = KQC + (size_t)(b * SEQ + tok0 + row) * DM + h * 128 + d0;
        conv16(P, l, b, tok0 + row, C_QKM + 512 + h * 128 + d0, 512 + h * 128 + d0, 0.08838834764831845f, kv);
        u32x4 w0, w1;
        w0.x = pk2(kv[0], kv[1]); w0.y = pk2(kv[2], kv[3]); w0.z = pk2(kv[4], kv[5]); w0.w = pk2(kv[6], kv[7]); w1.x = pk2(kv[8], kv[9]); w1.y = pk2(kv[10], kv[11]); w1.z = pk2(kv[12], kv[13]); w1.w = pk2(kv[14], kv[15]);
        *(u32x4*)(Kt + tb_off(row, d0)) = w0; *(u32x4*)(Kt + tb_off(row, d0 + 8)) = w1;
        *(u32x4*)(kq + 512) = w0; *(u32x4*)(kq + 520) = w1;
        conv16(P, l, b, tok0 + row, C_QKM + h * 128 + d0, h * 128 + d0, 1.0f, kv);
        w0.x = pk2(kv[0], kv[1]); w0.y = pk2(kv[2], kv[3]); w0.z = pk2(kv[4], kv[5]); w0.w = pk2(kv[6], kv[7]); w1.x = pk2(kv[8], kv[9]); w1.y = pk2(kv[10], kv[11]); w1.z = pk2(kv[12], kv[13]); w1.w = pk2(kv[14], kv[15]);
        *(u32x4*)(kq) = w0; *(u32x4*)(kq + 8) = w1;
    }
    LDS_WAIT();
    float* LC = (float*)(P.ws + WS_LC) + (size_t)u * 16384;
#pragma unroll 1
    for (int eb = 0; eb < 4; ++eb) {
#pragma unroll
        for (int it = 0; it < 4; ++it) { const int row = it * 16 + (lane >> 2), pc = lane & 3;
            const u32x4 x = *(const u32x4*)(PROJ + (size_t)(b * SEQ + tok0 + row) * PLD + C_VM + h * 128 + 32 * eb + 8 * pc); const float w = wS[row];
            u32x4 y; y.x = pk2(bf2f(x.x & 0xffffu) * w, bf2f(x.x >> 16) * w); y.y = pk2(bf2f(x.y & 0xffffu) * w, bf2f(x.y >> 16) * w); y.z = pk2(bf2f(x.z & 0xffffu) * w, bf2f(x.z >> 16) * w); y.w = pk2(bf2f(x.w & 0xffffu) * w, bf2f(x.w >> 16) * w);
            *(u32x4*)(Vb + row * 32 + 8 * pc) = y; }
        LDS_WAIT();
        f32x16 acc[4]; acc[0] = f32x16{}; acc[1] = f32x16{}; acc[2] = f32x16{}; acc[3] = f32x16{};
#pragma unroll
        for (int st = 0; st < 4; ++st) { const bf16x8 a = ldtr_nat(Vb, 0, 16 * st, lane);
#pragma unroll
            for (int db = 0; db < 4; ++db) acc[db] = mfma32(a, ldtr_nat(Kt, db, 16 * st, lane), acc[db]); }
#pragma unroll
        for (int db = 0; db < 4; ++db)
#pragma unroll
            for (int i = 0; i < 16; ++i) LC[(32 * eb + rowmap(i, hh)) * 128 + 32 * db + r32] = acc[db][i];
        LDS_WAIT();
    }
    {
        float n0 = 0.f, n1 = 0.f;
#pragma unroll 8
        for (int s = 0; s < 64; ++s) { const float w = wS[s]; n0 += w * bf2f(Kt[tb_off(s, lane)]); n1 += w * bf2f(Kt[tb_off(s, lane + 64)]); }
        float* NL = (float*)(P.ws + WS_NL) + (size_t)u * 128; NL[lane] = n0; NL[lane + 64] = n1;
    }
    LDS_WAIT();
}
__device__ __forceinline__ void mlstm_out_wave(const Params& P, unsigned char* ldsw, float* sc, int l, int uu, int lane) {
    const int u = uu >> 1, jt = uu & 1, bh = u >> 6, c = u & 63, b = bh >> 2, h = bh & 3, r32 = lane & 31, hh = lane >> 5, tok0 = 64 * c;
    bf16* Vt = (bf16*)ldsw; float* aS = sc; float* bS = sc + 64; float* GS = sc + 128;
    const float* GATES = (const float*)(P.ws + WS_GATES); const bf16* PROJ = (const bf16*)(P.ws + WS_PROJ); const bf16* KQC = (const bf16*)(P.ws + WS_XN);
    const float mprev = ((const float*)(P.ws + WS_MP))[u];
    {
        const float* gr = GATES + (size_t)(b * SEQ + tok0 + lane) * 32;
        const float lf = logsigmoidf_(gr[28 + h]), ig = gr[24 + h];
        const float a = wave_scan_add(lf, lane), bb = ig - a, pm = wave_scan_max(bb, lane);
        aS[lane] = a; bS[lane] = bb; GS[lane] = fmaxf(mprev, pm);
    }
    const int nrow = 32 * (jt + 1);
#pragma unroll 1
    for (int it = 0; it < nrow / 8; ++it) { const int row = it * 8 + (lane >> 3), d0 = 16 * (lane & 7);
        const bf16* vr = PROJ + (size_t)(b * SEQ + tok0 + row) * PLD + C_VM + h * 128 + d0;
        const u32x4 x0 = *(const u32x4*)vr, x1 = *(const u32x4*)(vr + 8);
        *(u32x4*)(Vt + tb_off(row, d0)) = x0; *(u32x4*)(Vt + tb_off(row, d0 + 8)) = x1; }
    LDS_WAIT();
    const int jl = 32 * jt + r32, trow = b * SEQ + tok0 + jl;
    bf16x8 qf[8];
    { const bf16* qrow = KQC + (size_t)trow * DM + h * 128 + 8 * hh;
#pragma unroll
        for (int st = 0; st < 8; ++st) qf[st] = ld8(qrow + 16 * st); }
    const float Gj = GS[jl], inter = __expf(mprev - Gj);
    float nq = 0.f;
    { const float* np = (const float*)(P.ws + WS_NP) + (size_t)u * 128 + 8 * hh;
#pragma unroll
        for (int st = 0; st < 8; ++st) { const f32x4 n0 = *(const f32x4*)(np + 16 * st), n1 = *(const f32x4*)(np + 16 * st + 4); const u32x4 qq = __builtin_bit_cast(u32x4, qf[st]);
            nq += n0[0] * bf2f(qq.x & 0xffffu) + n0[1] * bf2f(qq.x >> 16) + n0[2] * bf2f(qq.y & 0xffffu) + n0[3] * bf2f(qq.y >> 16)
                + n1[0] * bf2f(qq.z & 0xffffu) + n1[1] * bf2f(qq.z >> 16) + n1[2] * bf2f(qq.w & 0xffffu) + n1[3] * bf2f(qq.w >> 16); }
        nq += __shfl_xor(nq, 32); }
    bf16x8 pb[2][2]; float colsum = 0.f;
#pragma unroll
    for (int kt = 0; kt < 2; ++kt) {
        f32x16 sd = {};
        if (kt <= jt) {
            const bf16* krow = KQC + (size_t)(b * SEQ + tok0 + 32 * kt + r32) * DM + 512 + h * 128 + 8 * hh;
#pragma unroll
            for (int st = 0; st < 8; ++st) sd = mfma32(ld8(krow + 16 * st), qf[st], sd);
#pragma unroll
            for (int i = 0; i < 16; ++i) { const int s = 32 * kt + rowmap(i, hh); const float bsv = bS[s]; const float ev = __builtin_amdgcn_exp2f((bsv - Gj) * LOG2E); const float dv = (s <= jl) ? ev : 0.f; sd[i] *= dv; colsum += sd[i]; }
        }
        pb[kt][0] = pack8(sd, 0); pb[kt][1] = pack8(sd, 1);
        asm volatile("" ::: "memory");
    }
    f32x16 acc[4];
#pragma unroll
    for (int et = 0; et < 4; ++et) { acc[et] = f32x16{};
        const bf16* cp = (const bf16*)(P.ws + WS_CP) + (size_t)u * 16384 + (32 * et + r32) * 128 + 8 * hh;
#pragma unroll
        for (int st = 0; st < 8; ++st) acc[et] = mfma32(ld8(cp + 16 * st), qf[st], acc[et]);
#pragma unroll
        for (int i = 0; i < 16; ++i) acc[et][i] *= inter;
#pragma unroll
        for (int kt = 0; kt < 2; ++kt) { if (kt <= jt) {
#pragma unroll
            for (int s2 = 0; s2 < 2; ++s2) { const bf16* vb_ = Vt + et * 2048 + (32 * kt + 16 * s2 + 4 * hh + ((r32 & 15) >> 2)) * 32 + 16 * (r32 >> 4) + 4 * (r32 & 3);
                acc[et] = mfma32(ldtr8(vb_), pb[kt][s2], acc[et]); } } }
        asm volatile("" ::: "memory"); }
    colsum += __shfl_xor(colsum, 32);
    const float den = inter * nq + colsum, dn = fmaxf(fabsf(den), __expf(-(aS[jl] + Gj))), rdn = 1.0f / dn;
    float part = 0.f;
#pragma unroll
    for (int et = 0; et < 4; ++et)
#pragma unroll
        for (int q = 0; q < 4; ++q) { const int e0 = 32 * et + 8 * q + 4 * hh;
            const u32x2 ov = *(const u32x2*)(PROJ + (size_t)trow * PLD + C_OM + h * 128 + e0);
            const float o0 = bf2f(ov.x & 0xffffu), o1 = bf2f(ov.x >> 16), o2 = bf2f(ov.y & 0xffffu), o3 = bf2f(ov.y >> 16);
            acc[et][4 * q] *= rdn * sigmoidf_(o0); acc[et][4 * q + 1] *= rdn * sigmoidf_(o1); acc[et][4 * q + 2] *= rdn * sigmoidf_(o2); acc[et][4 * q + 3] *= rdn * sigmoidf_(o3);
            part += acc[et][4 * q] * acc[et][4 * q] + acc[et][4 * q + 1] * acc[et][4 * q + 1] + acc[et][4 * q + 2] * acc[et][4 * q + 2] + acc[et][4 * q + 3] * acc[et][4 * q + 3];
            if (q == 3) asm volatile("" ::: "memory"); }
    part += __shfl_xor(part, 32);
    const float rstd = rsqrtf(part * (1.0f / 128.0f) + EPSN);
    const float* ng = P.in[13] + (size_t)l * 512 + h * 128; bf16* Y = (bf16*)(P.ws + WS_Y) + (size_t)trow * DM + 512 + h * 128;
#pragma unroll
    for (int et = 0; et < 4; ++et)
#pragma unroll
        for (int q = 0; q < 4; ++q) { const int e0 = 32 * et + 8 * q + 4 * hh; const f32x4 gg = *(const f32x4*)(ng + e0);
            u32x2 w; w.x = pk2(acc[et][4 * q] * rstd * gg[0], acc[et][4 * q + 1] * rstd * gg[1]); w.y = pk2(acc[et][4 * q + 2] * rstd * gg[2], acc[et][4 * q + 3] * rstd * gg[3]);
            *(u32x2*)(Y + e0) = w; }
    LDS_WAIT();
}

constexpr int AL_KSC = 0, AL_KS = 36864, AL_VT = 73728, AL_IMPM = 36864, AL_IMPS = 53248, AL_SELB = 106496;
template <int MODE>
__device__ __forceinline__ void attn_tile(const bf16* Kt_, const bf16* Vt_, const bf16x8 (&qf)[4], f32x16 (&o)[2], float& m, float& l, float invl, int t, float slope2,
                                          int pos0, int posmul, bool lane_sel, float* IMPm, float* IMPs, int tokl, int jb, int r32, int hh) {
    f32x16 s[2]; s[0] = f32x16{}; s[1] = f32x16{};
#pragma unroll
    for (int st = 0; st < 4; ++st) { s[0] = mfma32(ld8(Kt_ + r32 * 72 + 16 * st + 8 * hh), qf[st], s[0]); s[1] = mfma32(ld8(Kt_ + (32 + r32) * 72 + 16 * st + 8 * hh), qf[st], s[1]); }
    const float C1 = 0.125f * LOG2E;
    float mx = -1.0e30f;
#pragma unroll
    for (int kt = 0; kt < 2; ++kt)
#pragma unroll
        for (int i = 0; i < 16; ++i) { const int keyl = 32 * kt + rowmap(i, hh); const int dist = t - (pos0 + posmul * keyl);
            bool valid = dist >= 0; if (MODE == 3) valid = valid && dist < 512; if (MODE == 2) valid = valid && lane_sel;
            const float v = valid ? (s[kt][i] * C1 - slope2 * (float)dist) : -1.0e30f; s[kt][i] = v; mx = fmaxf(mx, v); }
    if (MODE != 1) {
        mx = fmaxf(mx, __shfl_xor(mx, 32));
        const float mn = fmaxf(m, mx), alpha = __builtin_amdgcn_exp2f(m - mn); m = mn; l *= alpha;
        if (MODE >= 2) {
#pragma unroll
            for (int i = 0; i < 16; ++i) { o[0][i] *= alpha; o[1][i] *= alpha; } }
    }
    float ps = 0.f;
#pragma unroll
    for (int kt = 0; kt < 2; ++kt)
#pragma unroll
        for (int i = 0; i < 16; ++i) { const float v = s[kt][i]; float p = (v > -1.0e29f) ? __builtin_amdgcn_exp2f(v - m) : 0.f; if (MODE == 1) p *= invl; s[kt][i] = p; ps += p; }
    if (MODE != 1) l += ps;
    if (MODE == 0) return;
#pragma unroll
    for (int kt = 0; kt < 2; ++kt)
#pragma unroll
        for (int s2 = 0; s2 < 2; ++s2) { const bf16x8 pb = pack8(s[kt], s2);
            const bf16* vb_ = Vt_ + (32 * kt + 16 * s2 + 4 * hh + ((r32 & 15) >> 2)) * 32 + 16 * (r32 >> 4) + 4 * (r32 & 3);
            o[0] = mfma32(ldtr8(vb_), pb, o[0]);
            o[1] = mfma32(ldtr8(vb_ + 2048), pb, o[1]); }
    if (MODE == 1) {
#pragma unroll
        for (int kt = 0; kt < 2; ++kt)
#pragma unroll
            for (int q4 = 0; q4 < 4; ++q4) { float pp[4];
#pragma unroll
                for (int k = 0; k < 4; ++k) { float x = s[kt][4 * q4 + k]; x += __shfl_xor(x, 8); x += __shfl_xor(x, 16); pp[k] = x; }
                if (r32 < 8) { const int j = jb + 8 * kt + 2 * q4 + hh; IMPm[tokl * 64 + j] = pp[0] + pp[1] + pp[2] + 0.5f * pp[3]; if (j + 1 < 64) IMPs[tokl * 64 + j + 1] = 0.5f * pp[3]; } }
    }
}

__device__ __forceinline__ void attn_tile2(const bf16* Kt_, const bf16* Vt_, const bf16x8 (&qf)[4], f32x16 (&o)[2], float& m, float& l, int t, float slope2, int pos0, int maskmode, bool lane_sel, int r32, int hh) {
    f32x16 s[2]; s[0] = f32x16{}; s[1] = f32x16{};
    __builtin_amdgcn_s_setprio(1);
#pragma unroll
    for (int st = 0; st < 4; ++st) { s[0] = mfma32(ld8(Kt_ + r32 * 72 + 16 * st + 8 * hh), qf[st], s[0]); s[1] = mfma32(ld8(Kt_ + (32 + r32) * 72 + 16 * st + 8 * hh), qf[st], s[1]); }
    __builtin_amdgcn_s_setprio(0);
    const float C1 = 0.125f * LOG2E;
    const int dbi = t - pos0 - 4 * hh;
    const float b0 = lane_sel ? (-slope2 * (float)dbi - m) : -1.0e30f;
#pragma unroll
    for (int kt = 0; kt < 2; ++kt)
#pragma unroll
        for (int i = 0; i < 16; ++i) { const int cst = 32 * kt + (i & 3) + 8 * (i >> 2); s[kt][i] = fmaf(s[kt][i], C1, fmaf(slope2, (float)cst, b0)); }
    if (maskmode == 1) {
#pragma unroll
        for (int kt = 0; kt < 2; ++kt)
#pragma unroll
            for (int i = 0; i < 16; ++i) { const int cst = 32 * kt + (i & 3) + 8 * (i >> 2); s[kt][i] = (cst <= dbi) ? s[kt][i] : -1.0e30f; }
    } else if (maskmode == 2) {
#pragma unroll
        for (int kt = 0; kt < 2; ++kt)
#pragma unroll
            for (int i = 0; i < 16; ++i) { const int cst = 32 * kt + (i & 3) + 8 * (i >> 2); s[kt][i] = (dbi - cst < 512) ? s[kt][i] : -1.0e30f; }
    }
    float mx = -1.0e30f;
#pragma unroll
    for (int i = 0; i < 16; ++i) mx = fmaxf(mx, fmaxf(s[0][i], s[1][i]));
    mx = fmaxf(mx, __shfl_xor(mx, 32));
    if (__any(mx > 0.f)) {
        const float dl = fmaxf(mx, 0.f), alpha = __builtin_amdgcn_exp2f(-dl); m += dl; l *= alpha;
#pragma unroll
        for (int i = 0; i < 16; ++i) { o[0][i] *= alpha; o[1][i] *= alpha; s[0][i] -= dl; s[1][i] -= dl; }
    }
    float ps = 0.f;
#pragma unroll
    for (int kt = 0; kt < 2; ++kt)
#pragma unroll
        for (int i = 0; i < 16; ++i) { const float p = __builtin_amdgcn_exp2f(s[kt][i]); s[kt][i] = p; ps += p; }
    l += ps;
    __builtin_amdgcn_s_setprio(1);
#pragma unroll
    for (int kt = 0; kt < 2; ++kt)
#pragma unroll
        for (int s2 = 0; s2 < 2; ++s2) { const bf16x8 pb = pack8(s[kt], s2);
            const bf16* vb_ = Vt_ + (32 * kt + 16 * s2 + 4 * hh + ((r32 & 15) >> 2)) * 32 + 16 * (r32 >> 4) + 4 * (r32 & 3);
            o[0] = mfma32(ldtr8(vb_), pb, o[0]);
            o[1] = mfma32(ldtr8(vb_ + 2048), pb, o[1]); }
    __builtin_amdgcn_s_setprio(0);
}

__device__ __forceinline__ void attn_unit(const Params& P, unsigned char* lds, int l, int uid, int tid) {
    asm volatile("" : "+v"(tid));
    const int qt = uid >> 3, b = (uid >> 1) & 3, g = uid & 1, cur = qt;
    const int wave = tid >> 6, lane = tid & 63, r32 = lane & 31, hh = lane >> 5, tl = r32 & 7, r = r32 >> 3, tokl = 8 * wave + tl, t = 64 * qt + tokl, hd = 4 * g + r;
    const float slope2 = __builtin_amdgcn_exp2f(-(float)(hd + 1)) * LOG2E;
    bf16* KsC = (bf16*)(lds + AL_KSC); bf16* Ks = (bf16*)(lds + AL_KS); bf16* Vt = (bf16*)(lds + AL_VT);
    float* IMPm = (float*)(lds + AL_IMPM); float* IMPs = (float*)(lds + AL_IMPS); unsigned char* selb = lds + AL_SELB;
    const bf16* PROJ = (const bf16*)(P.ws + WS_PROJ); const float* GATES = (const float*)(P.ws + WS_GATES);
    const bf16* KCk = (const bf16*)(P.ws + WS_KC) + (size_t)((0 * 4 + b) * 2 + g) * 256 * 64; const bf16* KCv = (const bf16*)(P.ws + WS_KC) + (size_t)((1 * 4 + b) * 2 + g) * 256 * 64;
    const int lrow = tid >> 3, lch = tid & 7;
    for (int i = tid; i < 8192; i += NTHR) IMPm[i] = 0.f;
    bf16x8 qf[4];
    { const bf16* qrow = PROJ + (size_t)(b * SEQ + t) * PLD + C_QN + hd * 64 + 8 * hh;
#pragma unroll
        for (int st = 0; st < 4; ++st) qf[st] = ld8(qrow + 16 * st); }
    const float* grow = GATES + (size_t)(b * SEQ + t) * 32 + g * 12 + r * 3;
    const float gate_c = sigmoidf_(grow[0]), gate_s = sigmoidf_(grow[1]), gate_w = sigmoidf_(grow[2]);
    f32x16 outacc[2]; outacc[0] = f32x16{}; outacc[1] = f32x16{};
    f32x16 o[2];
    const int ntile = (4 * qt + 3 + 63) >> 6;
    for (int tile = 0; tile < ntile; ++tile) *(u32x4*)(KsC + tile * 4608 + lrow * 72 + lch * 8) = *(const u32x4*)(KCk + (size_t)(tile * 64 + lrow) * 64 + lch * 8);
    u32x4 vreg = *(const u32x4*)(KCv + (size_t)lrow * 64 + lch * 8), kreg = {0u, 0u, 0u, 0u};
#define VT_WRITE(buf, reg) (*(u32x4*)(Vt + (buf) * 4096 + (lch >> 2) * 2048 + lrow * 32 + (lch & 3) * 8) = (reg))
#define KS_WRITE(buf, reg) (*(u32x4*)(Ks + (buf) * 4608 + lrow * 72 + lch * 8) = (reg))
    VT_WRITE(0, vreg);
    __syncthreads();
    float m_c = -1.0e30f, l_c = 0.f;
    for (int tile = 0; tile < ntile; ++tile) attn_tile<0>(KsC + tile * 4608, nullptr, qf, o, m_c, l_c, 0.f, t, slope2, 1024 * tile + 31, 16, true, IMPm, IMPs, tokl, 16 * tile, r32, hh);
    { const float lt = l_c + __shfl_xor(l_c, 32); const float invl = lt > 0.f ? 1.0f / lt : 0.f;
        o[0] = f32x16{}; o[1] = f32x16{};
        for (int tile = 0; tile < ntile; ++tile) {
            if (tile + 1 < ntile) vreg = *(const u32x4*)(KCv + (size_t)((tile + 1) * 64 + lrow) * 64 + lch * 8);
            attn_tile<1>(KsC + tile * 4608, Vt + (tile & 1) * 4096, qf, o, m_c, l_c, invl, t, slope2, 1024 * tile + 31, 16, true, IMPm, IMPs, tokl, 16 * tile, r32, hh);
            if (tile + 1 < ntile) VT_WRITE((tile + 1) & 1, vreg);
            __syncthreads();
        }
#pragma unroll
        for (int i = 0; i < 16; ++i) { outacc[0][i] = gate_c * o[0][i]; outacc[1][i] = gate_c * o[1][i]; }
    }
    {
        const int tok = tid >> 3, sub = tid & 7; float vv[8];
#pragma unroll
        for (int k = 0; k < 8; ++k) { const int j = sub * 8 + k; float v = IMPm[tok * 64 + j] + IMPs[tok * 64 + j];
            if (j == 0 || j == cur || j == cur - 1) v += 1.0e4f;
            if (j > cur) v = -1.0f;
            vv[k] = v; }
#pragma unroll
        for (int k = 0; k < 8; ++k) IMPm[tok * 64 + sub * 8 + k] = vv[k];
        __syncthreads();
        unsigned bits = 0u;
#pragma unroll
        for (int k = 0; k < 8; ++k) { const int j = sub * 8 + k; int rank = 0;
#pragma unroll 4
            for (int j2 = 0; j2 < 64; ++j2) { const float x = IMPm[tok * 64 + j2]; rank += (x > vv[k] || (x == vv[k] && j2 < j)) ? 1 : 0; }
            if (rank < 16 && j <= cur) bits |= 1u << k; }
        selb[tok * 8 + sub] = (unsigned char)bits;
        __syncthreads();
    }
    const unsigned sel_lo = *(const unsigned*)(selb + tokl * 8), sel_hi = *(const unsigned*)(selb + tokl * 8 + 4);
    unsigned long long uni;
    { unsigned ulo = *(const unsigned*)(selb + lane * 8), uhi = *(const unsigned*)(selb + lane * 8 + 4);
#pragma unroll
        for (int of = 1; of < 64; of <<= 1) { ulo |= __shfl_xor(ulo, of); uhi |= __shfl_xor(uhi, of); }
        uni = ((unsigned long long)(unsigned)__builtin_amdgcn_readfirstlane(uhi) << 32) | (unsigned)__builtin_amdgcn_readfirstlane(ulo); }
    {
        unsigned long long it_uni = uni; int it_wj = cur; const int jlo = cur - 8 < 0 ? 0 : cur - 8;
#define TNEXT(dst) do { if (it_uni) { const int j_ = 63 - __builtin_clzll(it_uni); it_uni &= ~(1ull << j_); dst = j_; } else if (it_wj >= jlo) { dst = 256 + it_wj; --it_wj; } else dst = -1; } while (0)
#define TLOAD(kr, vr, code) do { const int br_ = (code) >> 8, j_ = (code) & 255; const bf16* rp_ = PROJ + (size_t)(b * SEQ + 64 * j_ + lrow) * PLD + C_KV + (2 + 2 * br_) * 128 + g * 64 + lch * 8; \
        kr = *(const u32x4*)rp_; vr = *(const u32x4*)(rp_ + 128); } while (0)
        float m_r = 0.f, l_r = 0.f; o[0] = f32x16{}; o[1] = f32x16{}; bool in_win = false;
#define TCOMPUTE(buf, code) do { const int br_ = (code) >> 8, j_ = (code) & 255; \
        if (br_ && !in_win) { in_win = true; const float lt_ = l_r + __shfl_xor(l_r, 32); const float sc_ = lt_ > 0.f ? gate_s / lt_ : 0.f; \
            _Pragma("unroll") for (int i = 0; i < 16; ++i) { outacc[0][i] += sc_ * o[0][i]; outacc[1][i] += sc_ * o[1][i]; } \
            m_r = 0.f; l_r = 0.f; o[0] = f32x16{}; o[1] = f32x16{}; } \
        if (br_) attn_tile2(Ks + (buf) * 4608, Vt + (buf) * 4096, qf, o, m_r, l_r, t, slope2, 64 * j_, (j_ == cur) ? 1 : ((j_ == cur - 8) ? 2 : 0), true, r32, hh); \
        else { const bool lsel_ = (j_ < 32 ? (sel_lo >> j_) : (sel_hi >> (j_ - 32))) & 1u; \
            if (__any(lsel_)) attn_tile2(Ks + (buf) * 4608, Vt + (buf) * 4096, qf, o, m_r, l_r, t, slope2, 64 * j_, (j_ == cur) ? 1 : 0, lsel_, r32, hh); } } while (0)
        const u32x4 z4 = {0u, 0u, 0u, 0u};
        u32x4 kA0, vA0, kA1 = z4, vA1 = z4, kB0 = z4, vB0 = z4, kB1 = z4, vB1 = z4;
        int c0, c1, n0, n1, nn0, nn1, t0_, t1_;
#define TLOAD2(k0, v0, k1, v1, a, b_) do { if ((a) >= 0) TLOAD(k0, v0, a); if ((b_) >= 0) TLOAD(k1, v1, b_); } while (0)
#define TWRITE2(st, k0, v0, k1, v1, a, b_) do { if ((a) >= 0) { KS_WRITE(2 * (st), k0); VT_WRITE(2 * (st), v0); } if ((b_) >= 0) { KS_WRITE(2 * (st) + 1, k1); VT_WRITE(2 * (st) + 1, v1); } } while (0)
        TNEXT(c0); TNEXT(c1); TNEXT(n0); TNEXT(n1);
        TLOAD2(kA0, vA0, kA1, vA1, c0, c1); TLOAD2(kB0, vB0, kB1, vB1, n0, n1);
        TWRITE2(0, kA0, vA0, kA1, vA1, c0, c1);
        __syncthreads();
        TNEXT(nn0); TNEXT(nn1); TLOAD2(kA0, vA0, kA1, vA1, nn0, nn1);
        for (;;) {
            TCOMPUTE(0, c0); if (c1 >= 0) TCOMPUTE(1, c1);
            TWRITE2(1, kB0, vB0, kB1, vB1, n0, n1);
            __syncthreads();
            if (n0 < 0) break;
            TNEXT(t0_); TNEXT(t1_); TLOAD2(kB0, vB0, kB1, vB1, t0_, t1_);
            c0 = n0; c1 = n1; n0 = nn0; n1 = nn1; nn0 = t0_; nn1 = t1_;
            TCOMPUTE(2, c0); if (c1 >= 0) TCOMPUTE(3, c1);
            TWRITE2(0, kA0, vA0, kA1, vA1, n0, n1);
            __syncthreads();
            if (n0 < 0) break;
            TNEXT(t0_); TNEXT(t1_); TLOAD2(kA0, vA0, kA1, vA1, t0_, t1_);
            c0 = n0; c1 = n1; n0 = nn0; n1 = nn1; nn0 = t0_; nn1 = t1_;
        }
#undef TLOAD2
#undef TWRITE2
        { const float lt = l_r + __shfl_xor(l_r, 32); const float sc = lt > 0.f ? gate_w / lt : 0.f;
#pragma unroll
            for (int i = 0; i < 16; ++i) { outacc[0][i] += sc * o[0][i]; outacc[1][i] += sc * o[1][i]; } }
#undef TNEXT
#undef TLOAD
#undef TCOMPUTE
    }
#undef VT_WRITE
#undef KS_WRITE
    bf16* Y = (bf16*)(P.ws + WS_Y) + (size_t)(b * SEQ + t) * DM + hd * 64;
#pragma unroll
    for (int db = 0; db < 2; ++db)
#pragma unroll
        for (int q4 = 0; q4 < 4; ++q4) { u32x2 w; w.x = pk2(outacc[db][4 * q4], outacc[db][4 * q4 + 1]); w.y = pk2(outacc[db][4 * q4 + 2], outacc[db][4 * q4 + 3]);
            *(u32x2*)(Y + 32 * db + 8 * q4 + 4 * hh) = w; }
}

#ifndef EXP_DUP
#define EXP_DUP -1
#endif
constexpr int N_PHASES = 21;
constexpr int MGU_A = MGU_P + 2624, MGU_B = MGU_A + 2560;
__global__ void __launch_bounds__(NTHR, 2) hybrid_fwd(Params P) {
    extern __shared__ __attribute__((aligned(16))) unsigned char lds[];
    cg::grid_group grid = cg::this_grid();
    const int G = gridDim.x, bx0 = blockIdx.x, NGW = G * NWAVES;
    const int wave0 = __builtin_amdgcn_readfirstlane((int)threadIdx.x >> 6);
#define IDS() int lane_; asm volatile("v_mbcnt_lo_u32_b32 %0, -1, 0\n\tv_mbcnt_hi_u32_b32 %0, -1, %0" : "=v"(lane_)); int wave_ = wave0, bx_ = bx0; asm volatile("" : "+s"(wave_), "+s"(bx_)); const int wave = wave_, bx = bx_, lane = lane_, tid = wave * 64 + lane, gw = bx * NWAVES + wave; (void)gw
    unsigned char* ws = P.ws;
    PG8_LAS unsigned char* glds = (PG8_LAS unsigned char*)lds;
#ifndef ONLY_KIND
#define ONLY_KIND -1
#endif
#ifndef ONLY_MASK
#define ONLY_MASK 0
#endif
#define KIND(x) ((ONLY_KIND < 0 && ONLY_MASK == 0) || ONLY_KIND == (x) || ((ONLY_MASK >> (x)) & 1))
#ifndef EXP_DUP
#define EXP_DUP -1
#endif
#define REPS(x) for (int rep_ = 0, nrep_ = ((EXP_DUP == (x)) ? 2 : 1); rep_ < nrep_; ++rep_)
#define RUN(k) (P.ph_lo <= (k) && (k) < P.ph_hi)
    if (threadIdx.x < 2) ((volatile LAS unsigned*)((LAS unsigned char*)lds + LDS_BAR_ST))[threadIdx.x] = 0u;
    __syncthreads();
    XcdBarrier xbar = xcd_barrier_post((unsigned*)(ws + WS_CTL) + CW_BAR + P.li * XCD_BAR_WORDS, (volatile LAS unsigned*)((LAS unsigned char*)lds + LDS_BAR_ST));
    if (P.ph_lo < 0) grid.sync();
#define SEAM(k) do { if (RUN(k) && RUN((k) + 1)) xcd_barrier(xbar); } while (0)
    if (RUN(0) && KIND(0)) { IDS(); REPS(0) prologue(P, lds, gw, NGW, wave, lane); }
    SEAM(0);
    for (int l = 0; l < 2; ++l) {
        const int pb = 1 + 9 * l;
        const float* xin = (l == 0) ? P.in[0] : P.out;
        if (RUN(pb + 0) && KIND(1)) { IDS(); REPS(1) rowpass<false>(P, lds, xin, P.in[4] + l * DM, l, 0, 1024, bx, G, tid, wave, lane); mod_finalize(P, l, bx, tid); }
        SEAM(pb + 0);
        if (RUN(pb + 1) && KIND(2)) { IDS();
            pg8::Gemm g{(const pg8::bf16_t*)(ws + WS_XN), (const pg8::bf16_t*)(ws + WS_WIN) + (size_t)l * NPROJ * DM, M, NPROJ, DM, 0, DM};
            pg8::StaticOrder S; S.init(M, NPROJ, G, bx);
            EpiProj E{(bf16*)(ws + WS_PROJ), (float*)(ws + WS_GATES), (const float*)(ws + WS_BIASP) + l * NPROJ};
            REPS(2) pg8::gemm_phase<EpiProj, pg8::StaticOrder, true, true>(glds, g, S, E, tid);
            if (G == 256 && bx >= 128) conv_moe_gu_items(P, (bf16*)(lds + wave * 16384), l == 0 ? MGU_P : MGU_B, l == 0 ? MGU_A : MGU_ITEMS, (bx - 128) * NWAVES + wave, 128 * NWAVES, lane);
            else if (G != 256 && l == 0) conv_moe_gu_items(P, (bf16*)(lds + wave * 16384), MGU_P, MGU_ITEMS, gw, NGW, lane);
        }
        SEAM(pb + 1);
        if (RUN(pb + 2)) { IDS();
            bf16* dscr = (bf16*)(lds + LDS_DCONV + wave * 9216);
            if (KIND(3)) REPS(3) for (int u = bx; u < 256; u += G) { CItem it = {nullptr, nullptr, 0, 0, 0}; f32x4 cv[16]; const bool hv = (l == 0) && ditem_decode(P, u * 8 + wave, lane, it); if (hv) conv_issue(it, cv); else conv_zero(cv);
                compress_unit(P, lds, l, u, tid); if (hv) conv_finish(it, cv, dscr, lane); }
            if (KIND(4)) REPS(4) for (int u = bx; u < 1024; u += G) { CItem it = {nullptr, nullptr, 0, 0, 0}; f32x4 cv[16]; const bool hv = (l == 0) && ditem_decode(P, 2048 + u * 8 + wave, lane, it); if (hv) conv_issue(it, cv); else conv_zero(cv);
                mlstm_local_unit(P, lds, l, u, tid); if (hv) conv_finish(it, cv, dscr, lane); }
        }
        SEAM(pb + 2);
        if (RUN(pb + 3)) { IDS();
            if (KIND(5)) REPS(5) mlstm_scan(P, bx, G, tid, wave, lane);
            if (KIND(6)) REPS(6) for (int u0 = bx; u0 < 256; u0 += G) { attn_unit(P, lds, l, u0, tid); attn_unit(P, lds, l, 511 - u0, tid); }
        }
        SEAM(pb + 3);
        if (RUN(pb + 4) && KIND(7)) { IDS(); REPS(7) for (int uu = gw; uu < 2048; uu += NGW) mlstm_out_wave(P, lds + wave * 16384, (float*)(lds + 131072 + 512 + wave * 1024), l, uu, lane); __syncthreads(); }
        SEAM(pb + 4);
        if (RUN(pb + 5) && KIND(8)) { IDS();
            pg8::Gemm g{(const pg8::bf16_t*)(ws + WS_Y), (const pg8::bf16_t*)(ws + WS_WOUT) + (size_t)l * DM * DM, M, DM, DM, 0, DM};
            pg8::StaticOrder S; S.init(M, DM, G, bx);
            REPS(8) { EpiRes E{xin, (rep_ + 1 < nrep_) ? (float*)(ws + WS_XG) : P.out, (const float*)(ws + WS_MODF), l, 2048};
            pg8::gemm_phase<EpiRes, pg8::StaticOrder, true, true>(glds, g, S, E, tid); }
        }
        SEAM(pb + 5);
        if (RUN(pb + 6) && KIND(9)) { IDS(); if (l == 0) rowpass<false>(P, lds, P.out, P.in[5], 0, 3072, 4096, bx, G, tid, wave, lane); else rowpass<true>(P, lds, P.out, P.in[5] + DM, 1, 3072, 4096, bx, G, tid, wave, lane); }
        SEAM(pb + 6);
        if (l == 0) {
            if (RUN(pb + 7) && KIND(10)) { IDS();
                pg8::Gemm g{(const pg8::bf16_t*)(ws + WS_XN), (const pg8::bf16_t*)(ws + WS_WGU), M, 2 * DFF, DM, 0, DM};
                pg8::StaticOrder S; S.init(M, 2 * DFF, G, bx);
                EpiSwiglu E{(bf16*)(ws + WS_HB), DFF};
                REPS(10) pg8::gemm_phase<EpiSwiglu, pg8::StaticOrder, true, true>(glds, g, S, E, tid);
                if (G == 256 && bx >= 128) conv_moe_gu_items(P, (bf16*)(lds + wave * 16384), MGU_A, MGU_B, (bx - 128) * NWAVES + wave, 128 * NWAVES, lane);
            }
            SEAM(pb + 7);
            if (RUN(pb + 8) && KIND(11)) { IDS();
                pg8::Gemm g{(const pg8::bf16_t*)(ws + WS_HB), (const pg8::bf16_t*)(ws + WS_WDN), M, DM, DFF, 0, DFF};
                pg8::StaticOrder S; S.init(M, DM, G, bx);
                REPS(11) { EpiRes E{P.out, (rep_ + 1 < nrep_) ? (float*)(ws + WS_XG) : P.out, (const float*)(ws + WS_MODF), 0, 5120};
                pg8::gemm_phase<EpiRes, pg8::StaticOrder, true, true>(glds, g, S, E, tid); }
            }
            SEAM(pb + 8);
        } else {
            if (RUN(pb + 7) && KIND(12)) { IDS(); moe_scatter(P, lds, bx, G, tid, wave, lane); conv_moe_dn_items(P, (bf16*)(lds + wave * 16384), gw, NGW, lane); }
            SEAM(pb + 7);
            if (RUN(pb + 8) && KIND(13)) { IDS();
                pg8::Gemm g{(const pg8::bf16_t*)(ws + WS_XG), (const pg8::bf16_t*)(ws + WS_MOE_GU), MAXR, 2 * DFFE, DM, (size_t)2 * DFFE * DM * 2, DM};
                MoeOrder S; S.init((const unsigned*)(ws + WS_CTL) + CW_CNT, 28, G, bx);
                EpiSwiglu E{(bf16*)(ws + WS_HG), DFFE};
                REPS(13) pg8::gemm_phase<EpiSwiglu, MoeOrder, true, true>(glds, g, S, E, tid);
            }
            SEAM(pb + 8);
            if (RUN(pb + 9) && KIND(14)) { IDS();
                MoeOrder S; S.init((const unsigned*)(ws + WS_CTL) + CW_CNT, 4, G, bx);
                const int total = S.total(), full = (total / G) * G, rest = total - full; const bool splitk = rest > 0 && rest <= 32;
                S.hi = splitk ? full : total;
                {   pg8::Gemm g{(const pg8::bf16_t*)(ws + WS_HG), (const pg8::bf16_t*)(ws + WS_MOE_DN), MAXR, DM, DFFE, (size_t)DM * DFFE * 2, DFFE};
                    EpiF32 E{(float*)(ws + WS_YG)};
                    REPS(14) pg8::gemm_phase<EpiF32, MoeOrder, true, true>(glds, g, S, E, tid); }
                if (splitk) {
                    MoeOrderT<4> S2; S2.init((const unsigned*)(ws + WS_CTL) + CW_CNT, 4, G, bx); S2.lo = full; S2.hi = total; S2.kpart = DFFE / 4;
                    pg8::Gemm g{(const pg8::bf16_t*)(ws + WS_HG), (const pg8::bf16_t*)(ws + WS_MOE_DN), MAXR, DM, DFFE / 4, (size_t)DM * DFFE * 2, DFFE};
                    EpiPart E{(float*)(ws + WS_PART)};
                    int lane2; asm volatile("v_mbcnt_lo_u32_b32 %0, -1, 0\n\tv_mbcnt_hi_u32_b32 %0, -1, %0" : "=v"(lane2));
                    pg8::gemm_phase<EpiPart, MoeOrderT<4>, true, true>(glds, g, S2, E, wave * 64 + lane2);
                    xcd_barrier(xbar);
                    int lane3; asm volatile("v_mbcnt_lo_u32_b32 %0, -1, 0\n\tv_mbcnt_hi_u32_b32 %0, -1, %0" : "=v"(lane3)); const int tid3 = wave * 64 + lane3;
                    const float* PART = (const float*)(ws + WS_PART); float* YG = (float*)(ws + WS_YG);
                    for (int idx = bx * NTHR + tid3; idx < rest * 16384; idx += G * NTHR) {
                        const int r = idx >> 14, w = idx & 16383, row = w >> 6, c4 = (w & 63) * 4;
                        pg8::Unit uu; MoeOrder S3 = S; S3.lo = full + r; S3.hi = full + r + 1; S3.c = 0; S3.next(0, uu);
                        const float* pp = PART + (size_t)(r * 4) * 65536 + row * 256 + c4;
                        const f32x4 v = (*(const f32x4*)pp + *(const f32x4*)(pp + 65536)) + (*(const f32x4*)(pp + 2 * 65536) + *(const f32x4*)(pp + 3 * 65536));
                        *(f32x4*)(YG + (size_t)(uu.pm * 256 + row) * DM + uu.pn * 256 + c4) = v; }
                }
            }
            SEAM(pb + 9);
        }
    }
    if (RUN(20) && KIND(15)) { IDS(); moe_combine_final(P, lds, bx, G, tid, wave, lane); }
#undef RUN
#undef SEAM
}

extern "C" void kernel_launch(void* const* d_in, const int* in_sizes, int n_in, void* d_out, int out_size, void* d_ws, size_t ws_size, hipStream_t stream) {
    static int grid = 0;
    if (grid == 0) {
        if (n_in != 23 || out_size != M * DM || ws_size < WS_END) { fprintf(stderr, "kernel_launch: unexpected shapes (n_in %d out %d ws %zu, need %zu)\n", n_in, out_size, ws_size, (size_t)WS_END); grid = -1; return; }
        int dev = 0, cus = 0, per_cu = 0;
        hipGetDevice(&dev); hipDeviceGetAttribute(&cus, hipDeviceAttributeMultiprocessorCount, dev);
        hipFuncSetAttribute((const void*)hybrid_fwd, hipFuncAttributeMaxDynamicSharedMemorySize, LDS_BYTES);
        if (hipOccupancyMaxActiveBlocksPerMultiprocessor(&per_cu, (const void*)hybrid_fwd, NTHR, LDS_BYTES) != hipSuccess || per_cu < 1) { fprintf(stderr, "kernel_launch: occupancy query says %d\n", per_cu); per_cu = 1; }
        (void)hipGetLastError();
        grid = cus;
        if (grid <= 0) grid = 256;
    }
    if (grid < 0) return;
    hipMemsetAsync((char*)d_ws + WS_CTL, 0, CTL_ZERO_BYTES, stream);
    Params p{};
    for (int i = 0; i < 23; ++i) p.in[i] = (const float*)d_in[i];
    p.out = (float*)d_out; p.ws = (unsigned char*)d_ws;
#if MK_PER_PHASE
    for (int ph = 0; ph < N_PHASES; ++ph) { p.ph_lo = ph; p.ph_hi = ph + 1; void* args[] = {&p};
        hipError_t e = hipLaunchCooperativeKernel((const void*)hybrid_fwd, dim3(grid), dim3(NTHR), args, LDS_BYTES, stream);
        if (e != hipSuccess) { fprintf(stderr, "cooperative launch (phase %d) failed: %s\n", ph, hipGetErrorString(e)); break; } }
#elif defined(PROBE_PHASE)
    for (int li = 0; li < 2; ++li) { p.li = li; p.ph_lo = li == 0 ? 0 : PROBE_PHASE; p.ph_hi = li == 0 ? PROBE_PHASE + 1 : N_PHASES; void* args[] = {&p};
        hipError_t e = hipLaunchCooperativeKernel((const void*)hybrid_fwd, dim3(grid), dim3(NTHR), args, LDS_BYTES, stream);
        if (e != hipSuccess) { fprintf(stderr, "cooperative launch failed: %s\n", hipGetErrorString(e)); break; } }
#else
    p.ph_lo = 0; p.ph_hi = N_PHASES; void* args[] = {&p};
    hipError_t e = hipLaunchCooperativeKernel((const void*)hybrid_fwd, dim3(grid), dim3(NTHR), args, LDS_BYTES, stream);
    if (e != hipSuccess) fprintf(stderr, "cooperative launch failed: %s (grid %d)\n", hipGetErrorString(e), grid);
#endif
}
```
